# Optimizing an MI355X kernel written in HIP

```python
import jax, jax.numpy as jnp
from jax import lax
import numpy as np

D_MODEL = 2048
BATCH = 1
SEQ = 8192
DEPTH = 4

GRID_W = 64
CTX_LEN = 256
D_MIX = D_MODEL
D_FF = ((8 * D_MODEL // 3 + 255) // 256) * 256
N_MOD = 9
EPS = 1e-6
ROPE_THETA = 10000.0
SGU_WIDTH = D_MIX // 4
SGU_GROUPS = 4
SGU_CH = SGU_WIDTH // SGU_GROUPS
SGU_CHUNK = 128
NA_WIDTH = D_MIX // 4
NA_HEADS = 8
NA_HD = NA_WIDTH // NA_HEADS
NA_WIN_H = 8
NA_WIN_W = 16
MLSTM_WIDTH = D_MIX - SGU_WIDTH - NA_WIDTH
MLSTM_HEADS = 8
MLSTM_HD = MLSTM_WIDTH // MLSTM_HEADS
MLSTM_CHUNK = 128
MLSTM_CONV_W = 5
IN_SIZES = (SGU_WIDTH, SGU_WIDTH, MLSTM_WIDTH, MLSTM_WIDTH, MLSTM_WIDTH, MLSTM_WIDTH, 4 * MLSTM_HEADS, NA_WIDTH, NA_WIDTH, NA_WIDTH)
D_IN = sum(IN_SIZES)
IN_SPLITS = tuple(int(s) for s in np.cumsum(IN_SIZES)[:-1])

kernel_name = 'hybrid_sgu_mlstm_natten_macaron_dit'


def rmsnorm(x, g):
    xf = x.astype(jnp.float32)
    y = xf * lax.rsqrt(jnp.mean(xf * xf, axis=-1, keepdims=True) + EPS)
    return (y * g.astype(jnp.float32)).astype(x.dtype)


def modulate(x, shift, scale):
    return x * (1 + scale) + shift


def swiglu(x, w13, w2):
    a, g = jnp.split(x @ w13, 2, axis=-1)
    return (jax.nn.silu(a) * g) @ w2


def spatial_gating(u, v, norm_g, w_s, b_s):
    B, T, _ = u.shape
    u, v = jax.nn.gelu(u), jax.nn.gelu(v)
    v = rmsnorm(v, norm_g).reshape(B, T // SGU_CHUNK, SGU_CHUNK, SGU_GROUPS, SGU_CH)
    mixed = jnp.einsum('gts,bnsgc->bntgc', w_s, v) + b_s.T[None, None, :, :, None]
    return u * mixed.reshape(B, T, SGU_WIDTH)


def dwconv(x, w, b):
    y = lax.conv_general_dilated(x, w[:, None, :], window_strides=(1,), padding='SAME',
                                 dimension_numbers=('NWC', 'WIO', 'NWC'), feature_group_count=x.shape[-1])
    return y + b


def axial_rope(x, row, col):
    half = x.shape[-1] // 2
    nf = half // 2
    freqs = ROPE_THETA ** (-jnp.arange(nf, dtype=jnp.float32) / nf)

    def rot(xa, pos):
        ang = pos[:, None] * freqs
        cos = jnp.cos(ang)[None, :, None, :].astype(x.dtype)
        sin = jnp.sin(ang)[None, :, None, :].astype(x.dtype)
        x1, x2 = xa[..., :nf], xa[..., nf:]
        return jnp.concatenate([x1 * cos - x2 * sin, x1 * sin + x2 * cos], axis=-1)

    return jnp.concatenate([rot(x[..., :half], row), rot(x[..., half:], col)], axis=-1)


def mlstm_zero_state(B):
    return (jnp.zeros((B, MLSTM_HEADS, MLSTM_HD, MLSTM_HD), jnp.float32),
            jnp.zeros((B, MLSTM_HEADS, MLSTM_HD), jnp.float32),
            jnp.zeros((B, MLSTM_HEADS), jnp.float32))


def mlstm_chunkwise(q, k, v, i_pre, f_pre, state):
    B, H, T, d = q.shape
    L = MLSTM_CHUNK
    nc = T // L

    def to_chunks(a):
        return jnp.moveaxis(a.reshape(a.shape[:2] + (nc, L) + a.shape[3:]), 2, 0)

    xs = tuple(to_chunks(a.astype(jnp.float32)) for a in (q, k, v, i_pre, jax.nn.log_sigmoid(f_pre.astype(jnp.float32))))
    tril = jnp.tril(jnp.ones((L, L), dtype=bool))

    def step(carry, inp):
        C, n, m = carry
        q_c, k_c, v_c, i_c, lf_c = inp
        b = jnp.cumsum(lf_c, axis=-1)
        d_mat = jnp.where(tril, b[..., :, None] - b[..., None, :] + i_c[..., None, :], -jnp.inf)
        inter = b + m[..., None]
        m_t = jnp.maximum(jnp.max(d_mat, axis=-1), inter)
        s = jnp.einsum('bhtd,bhsd->bhts', q_c, k_c) * jnp.exp(d_mat - m_t[..., None])
        a = jnp.exp(inter - m_t)
        num = a[..., None] * jnp.einsum('bhtd,bhde->bhte', q_c, C) + jnp.einsum('bhts,bhse->bhte', s, v_c)
        den = a * jnp.einsum('bhtd,bhd->bht', q_c, n) + jnp.sum(s, axis=-1)
        h = num / jnp.maximum(jnp.abs(den), jnp.exp(-m_t))[..., None]
        b_last = b[..., -1]
        g = b_last[..., None] - b + i_c
        m_new = jnp.maximum(b_last + m, jnp.max(g, axis=-1))
        w_k = jnp.exp(g - m_new[..., None])
        decay = jnp.exp(b_last + m - m_new)
        C = decay[..., None, None] * C + jnp.einsum('bhs,bhsd,bhse->bhde', w_k, k_c, v_c)
        n = decay[..., None] * n + jnp.einsum('bhs,bhsd->bhd', w_k, k_c)
        return (C, n, m_new), h

    state, h = lax.scan(step, state, xs)
    h = jnp.moveaxis(h, 0, 2).reshape(B, H, T, d)
    return h, state


def mlstm_prep(q, k, v, gates, conv_w, conv_b, gate_b, pos):
    B, T, _ = q.shape
    qk = jax.nn.silu(dwconv(jnp.concatenate([q, k], axis=-1), conv_w, conv_b))
    q, k = jnp.split(qk.reshape(B, T, 2 * MLSTM_HEADS, MLSTM_HD), 2, axis=2)
    if pos is not None:
        q, k = axial_rope(q, *pos), axial_rope(k, *pos)
    q = q * MLSTM_HD ** -0.5
    v = v.reshape(B, T, MLSTM_HEADS, MLSTM_HD)
    g = (gates.reshape(B, T, 4, MLSTM_HEADS).astype(jnp.float32) + gate_b.astype(jnp.float32)).transpose(2, 0, 3, 1)
    heads = lambda a: a.transpose(0, 2, 1, 3)
    return heads(q), heads(k), heads(v), g


def bidirectional_mlstm(lat, ctx):
    ql, kl, vl, gl = lat
    qc, kc, vc, gc = ctx
    flip = lambda a: jnp.flip(a, axis=2)
    zero = mlstm_zero_state(ql.shape[0])
    hc_f, st_f = mlstm_chunkwise(qc, kc, vc, gc[0], gc[1], zero)
    hl_f, _ = mlstm_chunkwise(ql, kl, vl, gl[0], gl[1], st_f)
    hc_b, st_b = mlstm_chunkwise(flip(qc), flip(kc), flip(vc), flip(gc[2]), flip(gc[3]), zero)
    hl_b, _ = mlstm_chunkwise(flip(ql), flip(kl), flip(vl), flip(gl[2]), flip(gl[3]), st_b)
    return hl_f + flip(hl_b), hc_f + flip(hc_b)


def mlstm_out(h, o, norm_g):
    B, H, T, d = h.shape
    h = rmsnorm(h.transpose(0, 2, 1, 3), norm_g.reshape(H, d)).reshape(B, T, H * d)
    return (jax.nn.sigmoid(o) * h).astype(o.dtype)


def na_heads(a):
    B, T, _ = a.shape
    return a.reshape(B, T, NA_HEADS, NA_HD)


def neighborhood_attention(q, k, v, k_ctx, v_ctx, rpb, rows):
    B, T, H, d = q.shape
    win_h = min(NA_WIN_H, rows)
    nk = win_h * NA_WIN_W
    qg = q.reshape(B, rows, GRID_W, H, d)
    kg = k.reshape(B, rows, GRID_W, H, d)
    vg = v.reshape(B, rows, GRID_W, H, d)
    cols = jnp.arange(GRID_W)
    col_idx = jnp.clip(cols - NA_WIN_W // 2, 0, GRID_W - NA_WIN_W)[:, None] + jnp.arange(NA_WIN_W)
    dc = col_idx - cols[:, None] + (NA_WIN_W - 1)
    r = jnp.arange(rows)
    row_start = jnp.clip(r - win_h // 2, 0, rows - win_h)
    dr = row_start[:, None] + jnp.arange(win_h) - r[:, None] + (NA_WIN_H - 1)
    scale = d ** -0.5

    def row_block(args):
        q_r, rs, dr_r = args
        k_r = lax.dynamic_slice_in_dim(kg, rs, win_h, axis=1)[:, :, col_idx]
        v_r = lax.dynamic_slice_in_dim(vg, rs, win_h, axis=1)[:, :, col_idx]
        bias = rpb[:, dr_r[:, None, None], dc[None]].transpose(0, 2, 1, 3).reshape(H, GRID_W, nk)
        s_loc = jnp.einsum('bqhd,bjqwhd->bhqjw', q_r, k_r).reshape(B, H, GRID_W, nk) * scale + bias
        s_ctx = jnp.einsum('bqhd,bchd->bhqc', q_r, k_ctx) * scale
        p = jax.nn.softmax(jnp.concatenate([s_loc, s_ctx], axis=-1).astype(jnp.float32), axis=-1).astype(v.dtype)
        p_loc = p[..., :nk].reshape(B, H, GRID_W, win_h, NA_WIN_W)
        return jnp.einsum('bhqjw,bjqwhd->bqhd', p_loc, v_r) + jnp.einsum('bhqc,bchd->bqhd', p[..., nk:], v_ctx)

    out = lax.map(row_block, (jnp.moveaxis(qg, 1, 0), row_start, dr))
    return jnp.moveaxis(out, 0, 1).reshape(B, T, H * d)


def context_attention(q, k, v):
    B, T, H, d = q.shape
    s = jnp.einsum('bqhd,bkhd->bhqk', q, k) * d ** -0.5
    p = jax.nn.softmax(s.astype(jnp.float32), axis=-1).astype(v.dtype)
    return jnp.einsum('bhqk,bkhd->bqhd', p, v).reshape(B, T, H * d)


def token_mixer(h_lat, h_ctx, w_in, w_out, sgu_norm_g, sgu_w, sgu_b, conv_w, conv_b, gate_b,
                mlstm_norm_g, rpb, pos, rows, need_ctx):
    p_lat = jnp.split(h_lat @ w_in, IN_SPLITS, axis=-1)
    p_ctx = jnp.split(h_ctx @ w_in, IN_SPLITS, axis=-1)
    a_lat = spatial_gating(p_lat[0], p_lat[1], sgu_norm_g, sgu_w, sgu_b)
    m_lat = mlstm_prep(p_lat[2], p_lat[3], p_lat[4], p_lat[6], conv_w, conv_b, gate_b, pos)
    m_ctx = mlstm_prep(p_ctx[2], p_ctx[3], p_ctx[4], p_ctx[6], conv_w, conv_b, gate_b, None)
    hm_lat, hm_ctx = bidirectional_mlstm(m_lat, m_ctx)
    b_lat = mlstm_out(hm_lat, p_lat[5], mlstm_norm_g)
    k_ctx, v_ctx = na_heads(p_ctx[8]), na_heads(p_ctx[9])
    c_lat = neighborhood_attention(na_heads(p_lat[7]), na_heads(p_lat[8]), na_heads(p_lat[9]), k_ctx, v_ctx, rpb, rows)
    y_lat = jnp.concatenate([a_lat, b_lat, c_lat], axis=-1) @ w_out
    if not need_ctx:
        return y_lat, None
    a_ctx = spatial_gating(p_ctx[0], p_ctx[1], sgu_norm_g, sgu_w, sgu_b)
    b_ctx = mlstm_out(hm_ctx, p_ctx[5], mlstm_norm_g)
    c_ctx_out = context_attention(na_heads(p_ctx[7]), k_ctx, v_ctx)
    y_ctx = jnp.concatenate([a_ctx, b_ctx, c_ctx_out], axis=-1) @ w_out
    return y_lat, y_ctx


def setup_inputs(seed: int = 0) -> dict:
    key = jax.random.key(seed)
    ks = jax.random.split(key, 24)
    nrm = lambda k, shape, s: jax.random.normal(k, shape, jnp.float32) * s
    D, L = D_MODEL, DEPTH
    f_base = jnp.linspace(3.0, 6.0, MLSTM_HEADS, dtype=jnp.float32)
    i_base = jnp.zeros((MLSTM_HEADS,), jnp.float32)
    gate_base = jnp.stack([i_base, f_base, i_base, f_base])
    return {
        'x': nrm(ks[0], (BATCH, SEQ, D), 1.0),
        'c': nrm(ks[1], (BATCH, D), 1.0),
        'ctx': nrm(ks[2], (BATCH, CTX_LEN, D), 1.0),
        'c_ctx': nrm(ks[3], (D,), 1.0),
        'ada_w': nrm(ks[4], (L, D, N_MOD * D), 0.5 * D ** -0.5),
        'ada_b': nrm(ks[5], (L, N_MOD * D), 0.02),
        'norm_g': 1.0 + nrm(ks[6], (L, 3, D), 0.05),
        'ffn1_w13': nrm(ks[7], (L, D, 2 * D_FF), D ** -0.5),
        'ffn1_w2': nrm(ks[8], (L, D_FF, D), D_FF ** -0.5),
        'ffn2_w13': nrm(ks[9], (L, D, 2 * D_FF), D ** -0.5),
        'ffn2_w2': nrm(ks[10], (L, D_FF, D), D_FF ** -0.5),
        'mix_w_in': nrm(ks[11], (L, D, D_IN), D ** -0.5),
        'mix_w_out': nrm(ks[12], (L, D_MIX, D), D_MIX ** -0.5),
        'sgu_norm_g': 1.0 + nrm(ks[13], (L, SGU_WIDTH), 0.05),
        'sgu_w': nrm(ks[14], (L, SGU_GROUPS, SGU_CHUNK, SGU_CHUNK), 0.5 * SGU_CHUNK ** -0.5),
        'sgu_b': 1.0 + nrm(ks[15], (L, SGU_GROUPS, SGU_CHUNK), 0.1),
        'mlstm_conv_w': nrm(ks[16], (L, MLSTM_CONV_W, 2 * MLSTM_WIDTH), MLSTM_CONV_W ** -0.5),
        'mlstm_conv_b': nrm(ks[17], (L, 2 * MLSTM_WIDTH), 0.02),
        'mlstm_gate_b': gate_base + nrm(ks[18], (L, 4, MLSTM_HEADS), 0.1),
        'mlstm_norm_g': 1.0 + nrm(ks[19], (L, MLSTM_WIDTH), 0.05),
        'na_rpb': nrm(ks[20], (L, NA_HEADS, 2 * NA_WIN_H - 1, 2 * NA_WIN_W - 1), 0.1),
        'final_norm_g': 1.0 + nrm(ks[21], (D,), 0.05),
    }


def reference(x, c, ctx, c_ctx, ada_w, ada_b, norm_g, ffn1_w13, ffn1_w2, ffn2_w13, ffn2_w2,
              mix_w_in, mix_w_out, sgu_norm_g, sgu_w, sgu_b, mlstm_conv_w, mlstm_conv_b,
              mlstm_gate_b, mlstm_norm_g, na_rpb, final_norm_g):
    B, T, _ = x.shape
    rows = T // GRID_W
    t = jnp.arange(T)
    pos = ((t // GRID_W).astype(jnp.float32), (t % GRID_W).astype(jnp.float32))
    h_lat, h_ctx = x, ctx
    for l in range(DEPTH):
        last = l == DEPTH - 1
        ml = jnp.split((jax.nn.silu(c) @ ada_w[l] + ada_b[l])[:, None, :], N_MOD, axis=-1)
        mc = jnp.split(jax.nn.silu(c_ctx) @ ada_w[l] + ada_b[l], N_MOD, axis=-1)
        ng = norm_g[l]
        h_lat = h_lat + 0.5 * ml[2] * swiglu(modulate(rmsnorm(h_lat, ng[0]), ml[0], ml[1]), ffn1_w13[l], ffn1_w2[l])
        h_ctx = h_ctx + 0.5 * mc[2] * swiglu(modulate(rmsnorm(h_ctx, ng[0]), mc[0], mc[1]), ffn1_w13[l], ffn1_w2[l])
        y_lat, y_ctx = token_mixer(modulate(rmsnorm(h_lat, ng[1]), ml[3], ml[4]),
                                   modulate(rmsnorm(h_ctx, ng[1]), mc[3], mc[4]),
                                   mix_w_in[l], mix_w_out[l], sgu_norm_g[l], sgu_w[l], sgu_b[l],
                                   mlstm_conv_w[l], mlstm_conv_b[l], mlstm_gate_b[l], mlstm_norm_g[l],
                                   na_rpb[l], pos, rows, not last)
        h_lat = h_lat + ml[5] * y_lat
        h_lat = h_lat + 0.5 * ml[8] * swiglu(modulate(rmsnorm(h_lat, ng[2]), ml[6], ml[7]), ffn2_w13[l], ffn2_w2[l])
        if not last:
            h_ctx = h_ctx + mc[5] * y_ctx
            h_ctx = h_ctx + 0.5 * mc[8] * swiglu(modulate(rmsnorm(h_ctx, ng[2]), mc[6], mc[7]), ffn2_w13[l], ffn2_w2[l])
    return rmsnorm(h_lat, final_norm_g)
```

```cpp
#include <hip/hip_runtime.h>
#include <cstdio>
#include <cstdint>

#ifndef MK_SPLIT
#define MK_SPLIT 0
#endif

#define GAS __attribute__((address_space(1)))
#define LAS __attribute__((address_space(3)))

namespace pg8 {
#define PG8_LAS __attribute__((address_space(3)))
typedef unsigned short bf16_t;
typedef short bf16x8 __attribute__((ext_vector_type(8)));
typedef float f32x4 __attribute__((ext_vector_type(4)));
typedef unsigned u32x4 __attribute__((ext_vector_type(4)));
constexpr int BM = 256, BK = 64, HALF = 128, HTB = HALF * BK * 2  , STAGE_BYTES = 8 * HTB, NXCD = 8, WGM = 8;

__host__ __device__ __forceinline__ int lds_byte(int r, int c) { const int st = (r >> 4) * 2 + (c >> 5), rr = r & 15, cc = c & 31, ob = rr * 64 + cc * 2; return st * 1024 + (ob ^ (((ob >> 9) & 1) << 5)); }
__host__ __device__ __forceinline__ void stage_rc(int b, int& R, int& C) { const int st = b / 1024, sb = b % 1024, swz = sb ^ (((sb >> 9) & 1) << 5); R = (st >> 1) * 16 + swz / 64; C = (st & 1) * 32 + (swz % 64) / 2; }
__host__ __device__ __forceinline__ int perm32(int rho) { const int n = rho >> 4, i = rho & 15; return 8 * (i >> 2) + 4 * n + (i & 3); }

struct Unit { int pm, pn, koff; };
struct Gemm { const bf16_t* A; const bf16_t* Bt; int ld, K; };

struct StaticOrder {
    int nM, nN, nwg, G, c;
    __host__ __device__ void init(int M, int N, int G_, int c_) { nM = M / BM; nN = N / BM; nwg = nM * nN; G = G_; c = c_; }
    __host__ __device__ bool next(int i, Unit& u) const {
        const long L = (long)i * G + c; if (L >= nwg) return false;
        int wgid = (int)L; { const int q = nwg / NXCD, r = nwg % NXCD, xcd = wgid % NXCD, off = wgid / NXCD; wgid = (xcd < r ? xcd * (q + 1) : r * (q + 1) + (xcd - r) * q) + off; }
        const int nig = WGM * nN, gid = wgid / nig, fm = gid * WGM, gsz = (nM - fm) < WGM ? (nM - fm) : WGM;
        u.pm = fm + ((wgid % nig) % gsz); u.pn = (wgid % nig) / gsz; u.koff = 0; return true;
    }
    __device__ __forceinline__ void a_ready(const Unit&) const {}
    __device__ __forceinline__ void done(const Unit&) const {}
};
struct SplitKOrder {
    int nN, nK, kslice, G, c;
    __host__ __device__ bool next(int i, Unit& u) const {
        const long L = (long)i * G + c; if (L >= (long)nN * nK) return false;
        u.pm = 0; u.pn = (int)(L % nN); u.koff = (int)(L / nN) * kslice; return true;
    }
    __device__ __forceinline__ void a_ready(const Unit&) const {}
    __device__ __forceinline__ void done(const Unit&) const {}
};

__device__ __forceinline__ unsigned cvt_pk_bf16(float lo, float hi) { unsigned r; asm volatile("v_cvt_pk_bf16_f32 %0, %1, %2" : "=v"(r) : "v"(lo), "v"(hi)); return r; }
__device__ __forceinline__ float silu_f(float a) { return a * __builtin_amdgcn_rcpf(1.0f + __expf(-a)); }

struct EpiSwiGLU {
    static constexpr bool PERM = true, AFTER_DRAIN = false;
    bf16_t* O; int ldc;
    __device__ __forceinline__ void operator()(const f32x4 (&acc)[2][2][4][2], const Unit& u, int wr, int wc, int fr, int fq) const {
        const int row0 = u.pm * BM + wr * 64 + fr, col0 = u.pn * HALF + wc * 32 + 8 * fq;
#pragma unroll
        for (int ai = 0; ai < 2; ++ai)
#pragma unroll
            for (int m = 0; m < 4; ++m) { bf16_t* rowp = O + (size_t)(row0 + ai * HALF + m * 16) * ldc + col0;
                const f32x4 a0 = acc[ai][0][m][0], a1 = acc[ai][0][m][1], g0 = acc[ai][1][m][0], g1 = acc[ai][1][m][1];
                u32x4 w; w.x = cvt_pk_bf16(silu_f(a0[0]) * g0[0], silu_f(a0[1]) * g0[1]); w.y = cvt_pk_bf16(silu_f(a0[2]) * g0[2], silu_f(a0[3]) * g0[3]);
                w.z = cvt_pk_bf16(silu_f(a1[0]) * g1[0], silu_f(a1[1]) * g1[1]); w.w = cvt_pk_bf16(silu_f(a1[2]) * g1[2], silu_f(a1[3]) * g1[3]);
                *(u32x4*)rowp = w; }
    }
};
template <bool ATOMIC> struct EpiResid {
    static constexpr bool PERM = false, AFTER_DRAIN = false;
    float* H; const float* gl; const float* gc; int row_off;
    __device__ __forceinline__ void operator()(const f32x4 (&acc)[2][2][4][2], const Unit& u, int wr, int wc, int fr, int fq) const {
        const int rowt = u.pm * BM + row_off; const float* gate = (rowt >= 8192) ? gc : gl;
        const int row0 = rowt + wr * 64 + fr, col0 = u.pn * BM + wc * 32 + 4 * fq;
        f32x4 gv[2][2];
#pragma unroll
        for (int bj = 0; bj < 2; ++bj)
#pragma unroll
            for (int n = 0; n < 2; ++n) gv[bj][n] = *(const f32x4*)(gate + col0 + bj * HALF + n * 16);
#pragma unroll
        for (int ai = 0; ai < 2; ++ai)
#pragma unroll
            for (int m = 0; m < 4; ++m) { float* rowp = H + (size_t)(row0 + ai * HALF + m * 16) * 2048 + col0;
#pragma unroll
                for (int bj = 0; bj < 2; ++bj)
#pragma unroll
                    for (int n = 0; n < 2; ++n) { float* p = rowp + bj * HALF + n * 16; const f32x4 v = gv[bj][n] * acc[ai][bj][m][n];
                        if (ATOMIC) { unsafeAtomicAdd(p + 0, v[0]); unsafeAtomicAdd(p + 1, v[1]); unsafeAtomicAdd(p + 2, v[2]); unsafeAtomicAdd(p + 3, v[3]); }
                        else { *(f32x4*)p = *(const f32x4*)p + v; } }
                asm volatile("" ::: "memory"); }
    }
};
struct EpiWin {
    static constexpr bool PERM = true, AFTER_DRAIN = false;
    bf16_t* P; float* GATES; const float* gate_b;
    __device__ __forceinline__ void operator()(const f32x4 (&acc)[2][2][4][2], const Unit& u, int wr, int wc, int fr, int fq) const {
        const int row0 = u.pm * BM + wr * 64 + fr;
        if (u.pn < 26) {
            const int col0 = u.pn * BM + wc * 32 + 8 * fq;
#pragma unroll
            for (int ai = 0; ai < 2; ++ai)
#pragma unroll
                for (int m = 0; m < 4; ++m) { bf16_t* rowp = P + (size_t)(row0 + ai * HALF + m * 16) * 6912 + col0;
#pragma unroll
                    for (int bj = 0; bj < 2; ++bj) { const f32x4 v0 = acc[ai][bj][m][0], v1 = acc[ai][bj][m][1];
                        u32x4 w; w.x = cvt_pk_bf16(v0[0], v0[1]); w.y = cvt_pk_bf16(v0[2], v0[3]); w.z = cvt_pk_bf16(v1[0], v1[1]); w.w = cvt_pk_bf16(v1[2], v1[3]);
                        *(u32x4*)(rowp + bj * HALF) = w; } }
        } else if (wc == 0) {
            const f32x4 b0 = *(const f32x4*)(gate_b + 8 * fq), b1 = *(const f32x4*)(gate_b + 8 * fq + 4);
#pragma unroll
            for (int ai = 0; ai < 2; ++ai)
#pragma unroll
                for (int m = 0; m < 4; ++m) { float* rowp = GATES + (size_t)(row0 + ai * HALF + m * 16) * 32 + 8 * fq;
                    *(f32x4*)rowp = acc[ai][0][m][0] + b0; *(f32x4*)(rowp + 4) = acc[ai][0][m][1] + b1; }
        }
    }
};

template <class Epi, class Sched, bool ALIGN_EPI = false, bool SP2 = false>
__device__ __forceinline__ void gemm_phase(PG8_LAS unsigned char* lds, const Gemm g, const Sched& S, const Epi& E) {
    int tid_ = threadIdx.x; asm volatile("" : "+v"(tid_));
    const int tid = tid_, wid = __builtin_amdgcn_readfirstlane(tid >> 6), lane = tid & 63, wr = wid >> 2, wc = wid & 3, fr = lane & 15, fq = lane >> 4;
    const int ld = g.ld; int nt = g.K / BK; asm volatile("" : "+s"(nt));
    unsigned voffA[2], voffB[2];
#pragma unroll
    for (int i = 0; i < 2; ++i) { int R, C; stage_rc(tid * 16 + i * 8192, R, C); const int Rb = Epi::PERM ? ((R & ~31) + perm32(R & 31)) : R;
        voffA[i] = (unsigned)(R * ld + C) * 2u; voffB[i] = (unsigned)(Rb * ld + C) * 2u; }
    const size_t kstep = (size_t)(BK * 2);
    const size_t hstep = (size_t)HALF * ld * 2;
    const size_t tstep = 2 * hstep;
    const unsigned ldsw = (unsigned)wid * 1024u;
    const int aoff = lds_byte(wr * 64 + fr, fq * 8), boff = lds_byte(wc * 32 + fr, fq * 8);
#define PG8_SA(b, h) (((b) * 2 + (h)) * HTB)
#define PG8_SB(b, h) ((4 + (b) * 2 + (h)) * HTB)
#define PG8_STAGE(bufoff, gbase, voff) do { _Pragma("unroll") for (int _i = 0; _i < 2; ++_i) \
        __builtin_amdgcn_global_load_lds((const unsigned*)((const char*)(gbase) + (voff)[_i]), (PG8_LAS unsigned*)(lds + (bufoff) + ldsw + _i * 8192), 16, 0, 0); } while (0)
#define PG8_LDA(dst, b, h) do { _Pragma("unroll") for (int m = 0; m < 4; ++m) _Pragma("unroll") for (int k = 0; k < 2; ++k) dst[m][k] = *(const PG8_LAS bf16x8*)(lds + PG8_SA(b, h) + aoff + m * 2048 + k * 1024); } while (0)
#define PG8_LDB(dst, b, h) do { _Pragma("unroll") for (int n = 0; n < 2; ++n) _Pragma("unroll") for (int k = 0; k < 2; ++k) dst[n][k] = *(const PG8_LAS bf16x8*)(lds + PG8_SB(b, h) + boff + n * 2048 + k * 1024); } while (0)
#define PG8_MMA(ai, bj, At, Bt) do { __builtin_amdgcn_s_setprio(1); _Pragma("unroll") for (int m = 0; m < 4; ++m) _Pragma("unroll") for (int n = 0; n < 2; ++n) _Pragma("unroll") for (int k = 0; k < 2; ++k) \
        acc[ai][bj][m][n] = __builtin_amdgcn_mfma_f32_16x16x32_bf16(Bt[n][k], At[m][k], acc[ai][bj][m][n], 0, 0, 0); __builtin_amdgcn_s_setprio(0); } while (0)
#define PG8_WAIT_V(n) asm volatile("s_waitcnt vmcnt(" #n ")" ::: "memory")
#define PG8_WAIT_L(n) asm volatile("s_waitcnt lgkmcnt(" #n ")" ::: "memory")
#define PG8_BAR __builtin_amdgcn_s_barrier()
#define PG8_SCHED __builtin_amdgcn_sched_barrier(0)
    Unit cur, nxt; int ui = 0;
    if (!S.next(0, cur)) return;
    f32x4 acc[2][2][4][2];
#pragma unroll
    for (int a = 0; a < 2; ++a)
#pragma unroll
        for (int b = 0; b < 2; ++b)
#pragma unroll
            for (int m = 0; m < 4; ++m)
#pragma unroll
                for (int n = 0; n < 2; ++n) acc[a][b][m][n] = (f32x4){0.f, 0.f, 0.f, 0.f};
    bf16x8 At[4][2], B0[2][2], B1[2][2];
    const char* cA = (const char*)g.A + (size_t)cur.pm * tstep + (size_t)cur.koff * 2; const char* cB = (const char*)g.Bt + (size_t)cur.pn * tstep + (size_t)cur.koff * 2;
    S.a_ready(cur);
    if constexpr (SP2) {
        PG8_STAGE(PG8_SB(0, 0), cB, voffB); PG8_STAGE(PG8_SB(0, 1), cB + hstep, voffB); PG8_STAGE(PG8_SA(0, 0), cA, voffA); PG8_STAGE(PG8_SA(0, 1), cA + hstep, voffA);
        if (wr == 1) PG8_BAR;
        PG8_WAIT_V(2); PG8_BAR;
        PG8_STAGE(PG8_SB(1, 0), cB + kstep, voffB); PG8_STAGE(PG8_SA(1, 0), cA + kstep, voffA); PG8_STAGE(PG8_SB(1, 1), cB + hstep + kstep, voffB);
        PG8_WAIT_V(6); PG8_BAR;
    } else {
        PG8_STAGE(PG8_SB(0, 0), cB, voffB); PG8_STAGE(PG8_SA(0, 0), cA, voffA); PG8_STAGE(PG8_SB(0, 1), cB + hstep, voffB); PG8_STAGE(PG8_SA(0, 1), cA + hstep, voffA);
        if (wr == 1) PG8_BAR;
        PG8_WAIT_V(4); PG8_BAR;
        PG8_STAGE(PG8_SB(1, 0), cB + kstep, voffB); PG8_STAGE(PG8_SA(1, 0), cA + kstep, voffA); PG8_STAGE(PG8_SB(1, 1), cB + hstep + kstep, voffB);
        PG8_WAIT_V(6); PG8_BAR;
    }
    for (;;) {
        const bool has_next = S.next(ui + 1, nxt);
        const char* nA = has_next ? (const char*)g.A + (size_t)nxt.pm * tstep + (size_t)nxt.koff * 2 : cA; const char* nB = has_next ? (const char*)g.Bt + (size_t)nxt.pn * tstep + (size_t)nxt.koff * 2 : cB;
        for (int t = 0; t < nt; t += 2) {
            const bool last = (t == nt - 2);
            const char* a1 = cA + (size_t)(t + 1) * kstep;
            const char* a2 = last ? nA : cA + (size_t)(t + 2) * kstep; const char* b2 = last ? nB : cB + (size_t)(t + 2) * kstep;
            const char* a3 = a2 + kstep; const char* b3 = b2 + kstep;
            if (last && has_next) S.a_ready(nxt);
            if constexpr (SP2) {
            PG8_LDB(B0, 0, 0); PG8_LDB(B1, 0, 1); PG8_SCHED; PG8_LDA(At, 0, 0); PG8_STAGE(PG8_SA(1, 1), a1 + hstep, voffA);
            PG8_WAIT_V(8); PG8_WAIT_L(0); PG8_BAR; PG8_MMA(0, 0, At, B0); PG8_MMA(0, 1, At, B1); PG8_BAR; PG8_SCHED;
            PG8_LDA(At, 0, 1); PG8_STAGE(PG8_SB(0, 0), b2, voffB); PG8_STAGE(PG8_SB(0, 1), b2 + hstep, voffB); PG8_STAGE(PG8_SA(0, 0), a2, voffA);
            PG8_WAIT_V(8); PG8_WAIT_L(0); PG8_BAR; PG8_MMA(1, 0, At, B0); PG8_MMA(1, 1, At, B1); PG8_BAR; PG8_SCHED;
            PG8_LDB(B0, 1, 0); PG8_LDB(B1, 1, 1); PG8_SCHED; PG8_LDA(At, 1, 0); PG8_STAGE(PG8_SA(0, 1), a2 + hstep, voffA);
            PG8_WAIT_V(8); PG8_WAIT_L(0); PG8_BAR; PG8_MMA(0, 0, At, B0); PG8_MMA(0, 1, At, B1); PG8_BAR; PG8_SCHED;
            PG8_LDA(At, 1, 1); PG8_STAGE(PG8_SB(1, 0), b3, voffB); PG8_STAGE(PG8_SB(1, 1), b3 + hstep, voffB); PG8_STAGE(PG8_SA(1, 0), a3, voffA);
            PG8_WAIT_V(8); PG8_WAIT_L(0); PG8_BAR; PG8_MMA(1, 0, At, B0); PG8_MMA(1, 1, At, B1); PG8_BAR; PG8_SCHED;
            } else {
            PG8_LDB(B0, 0, 0); PG8_SCHED; PG8_LDA(At, 0, 0); PG8_STAGE(PG8_SA(1, 1), a1 + hstep, voffA);
            PG8_WAIT_L(8); PG8_BAR; PG8_WAIT_L(0); PG8_MMA(0, 0, At, B0); PG8_BAR; PG8_SCHED;
            PG8_LDB(B1, 0, 1); PG8_STAGE(PG8_SB(0, 0), b2, voffB);
            PG8_BAR; PG8_WAIT_L(0); PG8_MMA(0, 1, At, B1); PG8_BAR;
            PG8_LDA(At, 0, 1); PG8_STAGE(PG8_SA(0, 0), a2, voffA);
            PG8_BAR; PG8_WAIT_L(0); PG8_MMA(1, 0, At, B0); PG8_BAR; PG8_SCHED;
            PG8_STAGE(PG8_SB(0, 1), b2 + hstep, voffB);
            PG8_WAIT_V(6); PG8_BAR; PG8_MMA(1, 1, At, B1); PG8_BAR;
            PG8_LDB(B0, 1, 0); PG8_SCHED; PG8_LDA(At, 1, 0); PG8_STAGE(PG8_SA(0, 1), a2 + hstep, voffA);
            PG8_WAIT_L(8); PG8_BAR; PG8_WAIT_L(0); PG8_MMA(0, 0, At, B0); PG8_BAR; PG8_SCHED;
            PG8_LDB(B1, 1, 1); PG8_STAGE(PG8_SB(1, 0), b3, voffB);
            PG8_BAR; PG8_WAIT_L(0); PG8_MMA(0, 1, At, B1); PG8_BAR;
            PG8_LDA(At, 1, 1); PG8_STAGE(PG8_SA(1, 0), a3, voffA);
            PG8_BAR; PG8_WAIT_L(0); PG8_MMA(1, 0, At, B0); PG8_BAR; PG8_SCHED;
            PG8_STAGE(PG8_SB(1, 1), b3 + hstep, voffB);
            PG8_WAIT_V(6); PG8_BAR; PG8_MMA(1, 1, At, B1); PG8_BAR;
            }
        }
        if constexpr (ALIGN_EPI) { if (wr == 0) PG8_BAR; }
        if constexpr (!Epi::AFTER_DRAIN) { E(acc, cur, wr, wc, fr, fq); S.done(cur); }
        if (!has_next) break;
#pragma unroll
        for (int a = 0; a < 2; ++a)
#pragma unroll
            for (int b = 0; b < 2; ++b)
#pragma unroll
                for (int m = 0; m < 4; ++m)
#pragma unroll
                    for (int n = 0; n < 2; ++n) acc[a][b][m][n] = (f32x4){0.f, 0.f, 0.f, 0.f};
        cur = nxt; cA = nA; cB = nB; ++ui;
        if constexpr (ALIGN_EPI) { if (wr == 1) PG8_BAR; }
    }
    PG8_WAIT_V(0);
    if constexpr (!ALIGN_EPI) { if (wr == 0) PG8_BAR; }
    PG8_BAR;
#undef PG8_SA
#undef PG8_SB
#undef PG8_STAGE
#undef PG8_LDA
#undef PG8_LDB
#undef PG8_MMA
#undef PG8_WAIT_V
#undef PG8_WAIT_L
#undef PG8_BAR
#undef PG8_SCHED
}
}

constexpr int D = 2048, SEQ = 8192, CTXL = 256, MTOK = SEQ + CTXL, DEPTH = 4, DFF = 5632, NMODV = 9 * D;
constexpr int DIN = 6688, DINP = 6912;
constexpr int NCHUNK = 66;
constexpr float EPS = 1e-6f;
constexpr int NWAVES = 8, NTHR = 512;
constexpr int PC_U = 0, PC_V = 512, PC_MQ = 1024, PC_MK = 2048, PC_MV = 3072, PC_MO = 4096, PC_NQ = 5120, PC_NK = 5632, PC_NV = 6144;

constexpr size_t MiB = 1u << 20;
constexpr size_t WS_CTL = 0, CTL_ZERO_BYTES = 1 * MiB;
constexpr size_t WS_MOD = 1 * MiB;
constexpr size_t WS_ROPE = 2 * MiB;
constexpr size_t WS_SGW = 3 * MiB;
constexpr size_t SZ_W13T = (size_t)2 * DFF * D * 2, SZ_W2T = (size_t)D * DFF * 2, SZ_WINT = (size_t)DINP * D * 2, SZ_WOUTT = (size_t)D * D * 2;
constexpr size_t WS_W13T = 4 * MiB;
constexpr size_t WS_W2T = WS_W13T + 8 * SZ_W13T;
constexpr size_t WS_WINT = WS_W2T + 8 * SZ_W2T;
constexpr size_t WS_WOUTT = WS_WINT + 4 * SZ_WINT;
constexpr size_t WS_H = WS_WOUTT + 4 * SZ_WOUTT;
constexpr size_t WS_ABUF = WS_H + (size_t)MTOK * D * 4;
constexpr size_t WS_CAT = WS_ABUF + (size_t)MTOK * D * 2;
constexpr size_t WS_HB = WS_CAT + (size_t)MTOK * D * 2;
constexpr size_t WS_P = WS_HB + (size_t)MTOK * DFF * 2;
constexpr size_t WS_GATES = WS_P + (size_t)MTOK * DINP * 2;
constexpr size_t WS_QC = WS_GATES + (size_t)MTOK * 32 * 4;
constexpr size_t WS_KC = WS_QC + (size_t)MTOK * 1024 * 2;
constexpr size_t WS_KCT = WS_KC + (size_t)MTOK * 1024 * 2;
constexpr size_t WS_MVT = WS_KCT + (size_t)MTOK * 1024 * 2;
constexpr size_t WS_NAVT = WS_MVT + (size_t)MTOK * 1024 * 2;
constexpr size_t WS_VNT = WS_NAVT + (size_t)MTOK * 512 * 2;
constexpr size_t WS_UT = WS_VNT + (size_t)MTOK * 512 * 2;
constexpr size_t WS_UN = WS_UT + (size_t)2 * NCHUNK * 8 * 128 * 128 * 4;
constexpr size_t WS_BLGM = WS_UN + (size_t)2 * NCHUNK * 8 * 128 * 4;
constexpr size_t WS_CT = WS_BLGM + 1 * MiB;
constexpr size_t WS_CN = WS_CT + (size_t)2 * NCHUNK * 8 * 128 * 128 * 2;
constexpr size_t WS_CM = WS_CN + (size_t)2 * NCHUNK * 8 * 128 * 4;
constexpr size_t WS_END = WS_CM + 1 * MiB;

constexpr int RING_BYTES = 131072, LDSCTL_OFF = RING_BYTES, LDS_BYTES = 147456;

typedef unsigned short bf16;
typedef short bf16x8 __attribute__((ext_vector_type(8)));
typedef short bf16x4 __attribute__((ext_vector_type(4)));
typedef float f32x4 __attribute__((ext_vector_type(4)));
typedef float f32x2 __attribute__((ext_vector_type(2)));
typedef unsigned u32x4 __attribute__((ext_vector_type(4)));
typedef unsigned u32x2 __attribute__((ext_vector_type(2)));
typedef __bf16 bf16x2_t __attribute__((ext_vector_type(2)));
typedef GAS unsigned gu32;
#define RLX_AGENT __ATOMIC_RELAXED, __HIP_MEMORY_SCOPE_AGENT
#define LDS_FENCE() asm volatile("s_waitcnt lgkmcnt(0)" ::: "memory")

__device__ __forceinline__ float bf2f(short b) { return __uint_as_float(((unsigned)(unsigned short)b) << 16); }
__device__ __forceinline__ unsigned pk2(float lo, float hi) { f32x2 v = {lo, hi}; bf16x2_t b = __builtin_convertvector(v, bf16x2_t); return __builtin_bit_cast(unsigned, b); }
__device__ __forceinline__ short f2bf(float f) { return (short)(pk2(f, 0.f) & 0xffffu); }
__device__ __forceinline__ bf16x4 pk4(float a, float b, float c, float d) { u32x2 w; w.x = pk2(a, b); w.y = pk2(c, d); return __builtin_bit_cast(bf16x4, w); }
__device__ __forceinline__ bf16x8 cat8(bf16x4 lo, bf16x4 hi) { return __builtin_shufflevector(lo, hi, 0, 1, 2, 3, 4, 5, 6, 7); }
__device__ __forceinline__ f32x4 mfma16(bf16x8 a, bf16x8 b, f32x4 c) { return __builtin_amdgcn_mfma_f32_16x16x32_bf16(a, b, c, 0, 0, 0); }
__device__ __forceinline__ float wsum(float v) {
#pragma unroll
    for (int o = 1; o < 64; o <<= 1) v += __shfl_xor(v, o);
    return v; }
__device__ __forceinline__ float wmax(float v) {
#pragma unroll
    for (int o = 1; o < 64; o <<= 1) v = fmaxf(v, __shfl_xor(v, o));
    return v; }
__device__ __forceinline__ float qsum(float v) { v += __shfl_xor(v, 16); v += __shfl_xor(v, 32); return v; }
__device__ __forceinline__ float qmax(float v) { v = fmaxf(v, __shfl_xor(v, 16)); v = fmaxf(v, __shfl_xor(v, 32)); return v; }
__device__ __forceinline__ float scan_up_add(float v, int lane) {
#pragma unroll
    for (int o = 1; o < 64; o <<= 1) { const float t = __shfl_up(v, o); if (lane >= o) v += t; }
    return v; }
__device__ __forceinline__ float scan_down_add(float v, int lane) {
#pragma unroll
    for (int o = 1; o < 64; o <<= 1) { const float t = __shfl_down(v, o); if (lane + o < 64) v += t; }
    return v; }
__device__ __forceinline__ float scan_up_max(float v, int lane) {
#pragma unroll
    for (int o = 1; o < 64; o <<= 1) { const float t = __shfl_up(v, o); if (lane >= o) v = fmaxf(v, t); }
    return v; }
__device__ __forceinline__ float scan_down_max(float v, int lane) {
#pragma unroll
    for (int o = 1; o < 64; o <<= 1) { const float t = __shfl_down(v, o); if (lane + o < 64) v = fmaxf(v, t); }
    return v; }
__device__ __forceinline__ float sigmoid_f(float a) { return __builtin_amdgcn_rcpf(1.0f + __expf(-a)); }
__device__ __forceinline__ float silu_f(float a) { return a * sigmoid_f(a); }
__device__ __forceinline__ float gelu_tanh(float x) { const float u = 1.5957691216057308f * (x + 0.044715f * x * x * x); return x * sigmoid_f(u); }
__device__ __forceinline__ float logsig(float x) { return fminf(x, 0.f) - log1pf(__expf(-fabsf(x))); }

#define XB_TMO      128
#define XB_XCNT(j)  (256  + 64 * (j))
#define XB_XSUB(j)  (1280 + 64 * (j))
#define XB_XGEN(j)  (2304 + 64 * (j))
#define XB_TOP      3328
#define XB_TOPGEN   3392
#define XCD_BAR_WORDS 3456
#define XB_SPIN_CAP (1u << 20)
__device__ __forceinline__ unsigned xb_ld(unsigned* p)              { return __hip_atomic_load(p, __ATOMIC_RELAXED, __HIP_MEMORY_SCOPE_AGENT); }
__device__ __forceinline__ unsigned xb_add(unsigned* p, unsigned v) { return __hip_atomic_fetch_add(p, v, __ATOMIC_RELAXED, __HIP_MEMORY_SCOPE_AGENT); }
__device__ __forceinline__ unsigned xb_xcc_id() { return (unsigned)__builtin_amdgcn_s_getreg((3 << 11) | 20) & 0xFu; }
#define XB_SPIN(cond, bar) do { unsigned _sp = 0; while (cond) { __builtin_amdgcn_s_sleep(1); \
    if ((++_sp & 255u) == 0u) { if (xb_ld(&(bar)[XB_TMO])) break; if (_sp > XB_SPIN_CAP) { atomicAdd(&(bar)[XB_TMO], 1u); break; } } } } while (0)
struct XcdBarrier { unsigned* bar; unsigned x; volatile LAS unsigned* st; };
__device__ __forceinline__ XcdBarrier xcd_barrier_post(unsigned* bar, volatile LAS unsigned* st) {
    XcdBarrier b; b.bar = bar; b.x = xb_xcc_id(); b.st = st;
    if (threadIdx.x == 0) (void)xb_add(&bar[XB_XCNT(b.x)], 1u);
    return b;
}
__device__ __forceinline__ void xcd_barrier_complete(unsigned* bar, unsigned x, unsigned& nloc, unsigned& nx) {
    const unsigned G = gridDim.x * gridDim.y * gridDim.z;
    unsigned sum, cnt, mine, sp = 0u;
    for (;;) {
        sum = 0u; cnt = 0u; mine = 0u;
#pragma unroll
        for (unsigned j = 0; j < 16; ++j) { const unsigned c = xb_ld(&bar[XB_XCNT(j)]); sum += c; cnt += (c > 0u) ? 1u : 0u; mine = (j == x) ? c : mine; }
        if (sum == G) break;
        __builtin_amdgcn_s_sleep(1);
        if ((++sp & 255u) == 0u) { if (xb_ld(&bar[XB_TMO])) break; if (sp > XB_SPIN_CAP) { atomicAdd(&bar[XB_TMO], 1u); break; } }
    }
    nloc = mine > 0u ? mine : 1u; nx = cnt > 0u ? cnt : 1u;
}
__device__ __forceinline__ void xcd_barrier(const XcdBarrier& b) {
    asm volatile("s_waitcnt vmcnt(0)" ::: "memory");
    __syncthreads();
    if (threadIdx.x == 0) {
        unsigned* bar = b.bar;
        __builtin_amdgcn_s_waitcnt(0);
        unsigned nloc = b.st[0], nx = b.st[1];
        if (nloc == 0u) { xcd_barrier_complete(bar, b.x, nloc, nx); b.st[0] = nloc; b.st[1] = nx; }
        const unsigned old = xb_add(&bar[XB_XSUB(b.x)], 1u);
        const unsigned gen = old / nloc;
        if (old + 1u == (gen + 1u) * nloc) {
            __builtin_amdgcn_fence(__ATOMIC_RELEASE, "agent");
            asm volatile("s_waitcnt vmcnt(0)" ::: "memory");
            const unsigned og = xb_add(&bar[XB_TOP], 1u);
            const unsigned tg = og / nx;
            if (og + 1u == (tg + 1u) * nx) xb_add(&bar[XB_TOPGEN], 1u);
            else XB_SPIN(xb_ld(&bar[XB_TOPGEN]) == tg, bar);
            __builtin_amdgcn_fence(__ATOMIC_ACQUIRE, "agent");
            xb_add(&bar[XB_XGEN(b.x)], 1u);
            asm volatile("s_waitcnt vmcnt(0)" ::: "memory");
        } else {
            XB_SPIN(xb_ld(&bar[XB_XGEN(b.x)]) == gen, bar);
            __builtin_amdgcn_fence(__ATOMIC_ACQUIRE, "agent");
            asm volatile("s_waitcnt vmcnt(0)" ::: "memory");
        }
    }
    __syncthreads();
}

struct Args { const float* in[22]; float* out; unsigned char* ws; int step_lo, step_hi; };

struct Frame {
    LAS unsigned char* lds;
    int tid, lane, wave, G;
    const float* const* in;
    float* out; unsigned char* ws;
};

__device__ __forceinline__ void frame_site(Frame& F, const Args& args) { int t = threadIdx.x; asm volatile("" : "+v"(t)); F.tid = t; F.lane = t & 63; F.wave = __builtin_amdgcn_readfirstlane(t >> 6);
    int z; asm volatile("s_mov_b32 %0, 0" : "=s"(z));
    F.in = args.in + z; F.ws = args.ws + z; F.out = args.out + z; }
__device__ __forceinline__ void frame_tid(Frame& F) { int t = threadIdx.x; asm volatile("" : "+v"(t)); F.tid = t; F.lane = t & 63; F.wave = __builtin_amdgcn_readfirstlane(t >> 6); }
enum { I_X = 0, I_C, I_CTX, I_CCTX, I_ADAW, I_ADAB, I_NORMG, I_F1W13, I_F1W2, I_F2W13, I_F2W2, I_WIN, I_WOUT, I_SGNG, I_SGW, I_SGB, I_CONVW, I_CONVB, I_GATEB, I_MNG, I_RPB, I_FNG };

__device__ __forceinline__ void p0_transpose_item(const float* W, int K, int N, bf16* WT, int k0, int n0, int dst_row0, LAS float* scr, int lane) {
#pragma unroll 8
    for (int i = 0; i < 32; ++i) { const int kk = 2 * i + (lane >> 5); scr[kk * 33 + (lane & 31)] = W[(size_t)(k0 + kk) * N + n0 + (lane & 31)]; }
    LDS_FENCE();
    const int c = lane & 7;
#pragma unroll
    for (int j = 0; j < 4; ++j) { const int n = (lane >> 3) + 8 * j; const LAS float* s = scr + (8 * c) * 33 + n;
        u32x4 o; o.x = pk2(s[0 * 33], s[1 * 33]); o.y = pk2(s[2 * 33], s[3 * 33]); o.z = pk2(s[4 * 33], s[5 * 33]); o.w = pk2(s[6 * 33], s[7 * 33]);
        *(u32x4*)(WT + (size_t)(dst_row0 + n) * K + k0 + 8 * c) = o; }
    LDS_FENCE();
}
__device__ __forceinline__ int w13_dst(int n) { return n < DFF ? (n >> 7) * 256 + (n & 127) : ((n - DFF) >> 7) * 256 + 128 + ((n - DFF) & 127); }
__device__ __forceinline__ int win_dst(int n) { return n < 5120 ? n : (n < 5152 ? 6656 + (n - 5120) : n - 32); }

__device__ __forceinline__ void p0_prologue(Frame& F) {
    const int gw = blockIdx.x * NWAVES + F.wave, NGW = F.G * NWAVES;
    const int gt = blockIdx.x * NTHR + F.tid, NGT = F.G * NTHR;
    { const f32x4* x4 = (const f32x4*)F.in[I_X]; const f32x4* c4 = (const f32x4*)F.in[I_CTX]; f32x4* h4 = (f32x4*)(F.ws + WS_H);
      const int nx = SEQ * D / 4, nc = CTXL * D / 4;
      for (int i = gt; i < nx + nc; i += NGT) h4[i] = i < nx ? x4[i] : c4[i - nx]; }
    { float* rt = (float*)(F.ws + WS_ROPE);
      for (int i = gt; i < 128 * 32; i += NGT) { const int pos = i >> 5, fi = i & 31; const float fr = exp2f(-(float)fi * (13.287712379549449f / 32.0f)); float s, c; sincosf((float)pos * fr, &s, &c); rt[2 * i] = c; rt[2 * i + 1] = s; }
      const float* sw = F.in[I_SGW]; bf16* so = (bf16*)(F.ws + WS_SGW);
      for (int i = gt; i < DEPTH * 4 * 128 * 128 / 2; i += NGT) ((unsigned*)so)[i] = pk2(sw[2 * i], sw[2 * i + 1]); }
    { LAS float* sc = (LAS float*)(F.lds);
      LAS float* red = (LAS float*)(F.lds + 16384);
      for (int i = F.tid; i < 2 * D; i += NTHR) { const float v = i < D ? F.in[I_C][i] : F.in[I_CCTX][i - D]; sc[i] = silu_f(v); }
      __syncthreads();
      for (int it = blockIdx.x; it < DEPTH * 72; it += F.G) {
          const int l = it / 72, cg = it % 72, n0 = cg * 256 + 4 * F.lane;
          const float* W = F.in[I_ADAW] + (size_t)l * D * NMODV + n0;
          f32x4 al = {0.f, 0.f, 0.f, 0.f}, ac = {0.f, 0.f, 0.f, 0.f};
          const int kb = F.wave * 256;
#pragma unroll 8
          for (int k = 0; k < 256; ++k) { const f32x4 w = *(const f32x4*)(W + (size_t)(kb + k) * NMODV); al += w * sc[kb + k]; ac += w * sc[D + kb + k]; }
#pragma unroll
          for (int j = 0; j < 4; ++j) { red[(F.wave * 256 + 4 * F.lane + j) * 2] = al[j]; red[(F.wave * 256 + 4 * F.lane + j) * 2 + 1] = ac[j]; }
          __syncthreads();
          { const int col = F.tid >> 1, t = F.tid & 1; float s = 0.f;
#pragma unroll
            for (int w = 0; w < 8; ++w) s += red[(w * 256 + col) * 2 + t];
            const int n = cg * 256 + col; s += F.in[I_ADAB][l * NMODV + n];
            const int ch = n >> 11; if (ch == 2 || ch == 8) s *= 0.5f;
            ((float*)(F.ws + WS_MOD))[(size_t)(l * 2 + t) * NMODV + n] = s; }
          __syncthreads();
      }
    }
    { LAS float* scr = (LAS float*)(F.lds + F.wave * 16384);
      constexpr int I_13 = 32 * 352, I_2 = 88 * 64, I_IN = 32 * 209, I_OUT = 32 * 64, I_LAYER = 2 * I_13 + 2 * I_2 + I_IN + I_OUT;
      for (int it = gw; it < DEPTH * I_LAYER; it += NGW) {
          const int l = it / I_LAYER; int r = it % I_LAYER;
          if (r < 2 * I_13) { const int f = r / I_13; r %= I_13; const int kb = r / 352, nb = r % 352;
              p0_transpose_item(F.in[f ? I_F2W13 : I_F1W13] + (size_t)l * D * 2 * DFF, D, 2 * DFF, (bf16*)(F.ws + WS_W13T + (size_t)(l * 2 + f) * SZ_W13T), kb * 64, nb * 32, w13_dst(nb * 32), scr, F.lane); continue; }
          r -= 2 * I_13;
          if (r < 2 * I_2) { const int f = r / I_2; r %= I_2; const int kb = r / 64, nb = r % 64;
              p0_transpose_item(F.in[f ? I_F2W2 : I_F1W2] + (size_t)l * DFF * D, DFF, D, (bf16*)(F.ws + WS_W2T + (size_t)(l * 2 + f) * SZ_W2T), kb * 64, nb * 32, nb * 32, scr, F.lane); continue; }
          r -= 2 * I_2;
          if (r < I_IN) { const int kb = r / 209, nb = r % 209;
              p0_transpose_item(F.in[I_WIN] + (size_t)l * D * DIN, D, DIN, (bf16*)(F.ws + WS_WINT + (size_t)l * SZ_WINT), kb * 64, nb * 32, win_dst(nb * 32), scr, F.lane); continue; }
          r -= I_IN;
          { const int kb = r / 64, nb = r % 64;
              p0_transpose_item(F.in[I_WOUT] + (size_t)l * D * D, D, D, (bf16*)(F.ws + WS_WOUTT + (size_t)l * SZ_WOUTT), kb * 64, nb * 32, nb * 32, scr, F.lane); }
      }
    }
}

__device__ __forceinline__ void norm_phase(Frame& F, const float* g, const float* modl  , int ishift, int iscale, int M) {
    const int gw = blockIdx.x * NWAVES + F.wave, NGW = F.G * NWAVES;
    const float* H = (const float*)(F.ws + WS_H); bf16* A = (bf16*)(F.ws + WS_ABUF);
    for (int row = gw; row < M; row += NGW) {
        const int t = row >= SEQ ? 1 : 0;
        const float* sh = modl + (size_t)t * NMODV + ishift * D; const float* scl = modl + (size_t)t * NMODV + iscale * D;
        const f32x4* xr = (const f32x4*)(H + (size_t)row * D) + F.lane;
        f32x4 v[8]; float s = 0.f;
#pragma unroll
        for (int j = 0; j < 8; ++j) { v[j] = xr[64 * j]; s += (v[j][0] * v[j][0] + v[j][1] * v[j][1]) + (v[j][2] * v[j][2] + v[j][3] * v[j][3]); }
        const float rstd = rsqrtf(wsum(s) * (1.0f / D) + EPS);
        u32x2* o = (u32x2*)(A + (size_t)row * D) + F.lane;
#pragma unroll
        for (int j = 0; j < 8; ++j) { const int c = 4 * F.lane + 256 * j;
            const f32x4 gg = *(const f32x4*)(g + c), ss = *(const f32x4*)(scl + c), hh = *(const f32x4*)(sh + c);
            const f32x4 y = (v[j] * rstd) * gg * (ss + 1.0f) + hh;
            u32x2 w; w.x = pk2(y[0], y[1]); w.y = pk2(y[2], y[3]); o[64 * j] = w; }
    }
}
__device__ __forceinline__ void final_norm_phase(Frame& F) {
    const int gw = blockIdx.x * NWAVES + F.wave, NGW = F.G * NWAVES;
    const float* H = (const float*)(F.ws + WS_H); const float* g = F.in[I_FNG];
    for (int row = gw; row < SEQ; row += NGW) {
        const f32x4* xr = (const f32x4*)(H + (size_t)row * D) + F.lane;
        f32x4 v[8]; float s = 0.f;
#pragma unroll
        for (int j = 0; j < 8; ++j) { v[j] = xr[64 * j]; s += (v[j][0] * v[j][0] + v[j][1] * v[j][1]) + (v[j][2] * v[j][2] + v[j][3] * v[j][3]); }
        const float rstd = rsqrtf(wsum(s) * (1.0f / D) + EPS);
        f32x4* o = (f32x4*)(F.out + (size_t)row * D) + F.lane;
#pragma unroll
        for (int j = 0; j < 8; ++j) o[64 * j] = (v[j] * rstd) * *(const f32x4*)(g + 4 * F.lane + 256 * j);
    }
}

__device__ __forceinline__ void tile_rows_out(const LAS short* tile, bf16* dst, int row0, int tokb, int lane) {
    LDS_FENCE();
#pragma unroll
    for (int it = 0; it < 8; ++it) { const int idx = it * 64 + lane, r = idx >> 3, seg = idx & 7;
        const bf16x8 v = *(const LAS bf16x8*)(tile + r * 72 + 8 * seg);
        *(bf16x8*)(dst + (size_t)(row0 + r) * MTOK + tokb + 8 * seg) = v; }
    LDS_FENCE();
}
__device__ __forceinline__ void prep_transpose_item(const bf16* P, int c0, bf16* dst, int drow0, int tb, LAS short* tile, int lane) {
#pragma unroll
    for (int it = 0; it < 8; ++it) { const int idx = it * 64 + lane, tok = idx >> 3, seg = idx & 7;
        const bf16x8 v = *(const bf16x8*)(P + (size_t)(tb * 64 + tok) * DINP + c0 + 8 * seg);
#pragma unroll
        for (int j = 0; j < 8; ++j) tile[(8 * seg + j) * 72 + tok] = v[j]; }
    tile_rows_out(tile, dst, drow0, tb * 64, lane);
}
__device__ __forceinline__ void prep_conv_item(Frame& F, const bf16* P, const float* cw  , const float* cb, int tb, int cg, LAS short* tile, int lane) {
    const int i = lane & 31, ts = lane >> 5, ch0 = cg * 64 + i, ch1 = ch0 + 32;
    const bool isK = cg >= 16; const int half = cg & 1;
    const int tok0 = tb * 64, t0 = tok0 + 32 * ts;
    const int seq_lo = tok0 < SEQ ? 0 : SEQ, seq_hi = tok0 < SEQ ? SEQ : MTOK;
    float w0[5], w1[5];
#pragma unroll
    for (int j = 0; j < 5; ++j) { w0[j] = cw[j * 2048 + ch0]; w1[j] = cw[j * 2048 + ch1]; }
    const float b0 = cb[ch0], b1 = cb[ch1];
    const bf16* src = P + PC_MQ;
    float x0[5], x1[5];
#pragma unroll
    for (int j = 0; j < 4; ++j) { const int t = t0 + j - 2; const bool ok = t >= seq_lo && t < seq_hi;
        x0[j] = ok ? bf2f((short)src[(size_t)t * DINP + ch0]) : 0.f; x1[j] = ok ? bf2f((short)src[(size_t)t * DINP + ch1]) : 0.f; }
    const float* rope = (const float*)(F.ws + WS_ROPE);
    const bool lat = tok0 < SEQ;
    bf16* dstn = (bf16*)(F.ws + (isK ? WS_KC : WS_QC));
    const int chn0 = ch0 & 1023;
    const float qs = isK ? 1.0f : 0.08838834764831845f;
    for (int tt = 0; tt < 32; ++tt) {
        const int t = t0 + tt;
        { const int tn = t + 2; const bool ok = tn >= seq_lo && tn < seq_hi;
          x0[4] = ok ? bf2f((short)src[(size_t)tn * DINP + ch0]) : 0.f; x1[4] = ok ? bf2f((short)src[(size_t)tn * DINP + ch1]) : 0.f; }
        float y0 = b0, y1 = b1;
#pragma unroll
        for (int j = 0; j < 5; ++j) { y0 += w0[j] * x0[j]; y1 += w1[j] * x1[j]; }
        y0 = silu_f(y0); y1 = silu_f(y1);
        if (lat) { const int pos = half ? (t & 63) : (t >> 6); const float c = rope[(pos * 32 + i) * 2], s = rope[(pos * 32 + i) * 2 + 1];
            const float r0 = y0 * c - y1 * s, r1 = y0 * s + y1 * c; y0 = r0; y1 = r1; }
        y0 *= qs; y1 *= qs;
        const short o0 = f2bf(y0), o1 = f2bf(y1);
        dstn[(size_t)t * 1024 + chn0] = (bf16)o0; dstn[(size_t)t * 1024 + chn0 + 32] = (bf16)o1;
        if (isK) { tile[i * 72 + 32 * ts + tt] = o0; tile[(i + 32) * 72 + 32 * ts + tt] = o1; }
#pragma unroll
        for (int j = 0; j < 4; ++j) { x0[j] = x0[j + 1]; x1[j] = x1[j + 1]; }
    }
    if (isK) tile_rows_out(tile, (bf16*)(F.ws + WS_KCT), (cg - 16) * 64, tok0, lane);
}
__device__ __forceinline__ void prep_sgu_item(Frame& F, const bf16* P, const float* ng, int tb, int cg, LAS short* tile, int lane) {
    const int tok0 = tb * 64; float myr = 0.f;
    for (int tok = 0; tok < 64; ++tok) {
        const bf16x8 v = *(const bf16x8*)(P + (size_t)(tok0 + tok) * DINP + PC_V + 8 * lane); float s = 0.f;
#pragma unroll
        for (int j = 0; j < 8; ++j) { const float gl = gelu_tanh(bf2f(v[j])); s += gl * gl; }
        s = wsum(s); const float r = rsqrtf(s * (1.0f / 512.0f) + EPS); if (lane == tok) myr = r;
    }
    const bf16* rowp = P + (size_t)(tok0 + lane) * DINP + PC_V + cg * 64;
#pragma unroll
    for (int seg = 0; seg < 8; ++seg) { const bf16x8 v = *(const bf16x8*)(rowp + 8 * seg);
#pragma unroll
        for (int j = 0; j < 8; ++j) tile[(8 * seg + j) * 72 + lane] = f2bf(gelu_tanh(bf2f(v[j])) * myr * ng[cg * 64 + 8 * seg + j]); }
    tile_rows_out(tile, (bf16*)(F.ws + WS_VNT), cg * 64, tok0, lane);
}
__device__ __forceinline__ void prep_phase(Frame& F, int l) {
    const int gw = blockIdx.x * NWAVES + F.wave, NGW = F.G * NWAVES;
    const bf16* P = (const bf16*)(F.ws + WS_P);
    LAS short* tile = (LAS short*)(F.lds + F.wave * 16384);
    constexpr int NTB = MTOK / 64;
    constexpr int N_CONV = NTB * 32, N_SGU = NTB * 8, N_MVT = NTB * 16, N_NAVT = NTB * 8;
    for (int it = gw; it < N_CONV + N_SGU + N_MVT + N_NAVT; it += NGW) {
        int r = it;
        if (r < N_CONV) { prep_conv_item(F, P, F.in[I_CONVW] + (size_t)l * 5 * 2048, F.in[I_CONVB] + (size_t)l * 2048, r >> 5, r & 31, tile, F.lane); continue; } r -= N_CONV;
        if (r < N_SGU) { prep_sgu_item(F, P, F.in[I_SGNG] + (size_t)l * 512, r >> 3, r & 7, tile, F.lane); continue; } r -= N_SGU;
        if (r < N_MVT) { prep_transpose_item(P, PC_MV + (r & 15) * 64, (bf16*)(F.ws + WS_MVT), (r & 15) * 64, r >> 4, tile, F.lane); continue; } r -= N_MVT;
        prep_transpose_item(P, PC_NV + (r & 7) * 64, (bf16*)(F.ws + WS_NAVT), (r & 7) * 64, r >> 3, tile, F.lane);
    }
}

struct MG { float i_f[2], b_f[2], i_b[2], b_b[2]; float bl_f, bl_b; };
__device__ __forceinline__ void mlstm_gates(const float* G, int lane, MG& g) {
    float lf[2], lb[2];
#pragma unroll
    for (int x = 0; x < 2; ++x) { const float* p = G + (size_t)(lane + 64 * x) * 32; g.i_f[x] = p[0]; lf[x] = logsig(p[8]); g.i_b[x] = p[16]; lb[x] = logsig(p[24]); }
    const float s0 = scan_up_add(lf[0], lane), t0 = __shfl(s0, 63), s1 = scan_up_add(lf[1], lane) + t0;
    g.b_f[0] = s0; g.b_f[1] = s1; g.bl_f = __shfl(s1, 63);
    const float r1 = scan_down_add(lb[1], lane), t1 = __shfl(r1, 0), r0 = scan_down_add(lb[0], lane) + t1;
    g.b_b[0] = r0; g.b_b[1] = r1; g.bl_b = __shfl(r0, 0);
}
__device__ __forceinline__ void mlstm_local_unit(Frame& F, int c, int h, LAS float* wsl) {
    const int lane = F.lane, w = F.wave, fr = lane & 15, fq = lane >> 4, tok0 = c * 128;
    const int posf = (c + 2) % NCHUNK, posb = 65 - c;
    MG g; mlstm_gates((const float*)(F.ws + WS_GATES) + (size_t)tok0 * 32 + h, lane, g);
    float gf[2], gb[2];
#pragma unroll
    for (int x = 0; x < 2; ++x) { gf[x] = g.bl_f - g.b_f[x] + g.i_f[x]; gb[x] = g.bl_b - g.b_b[x] + g.i_b[x]; }
    const float gmf = wmax(fmaxf(gf[0], gf[1])), gmb = wmax(fmaxf(gb[0], gb[1]));
    wsl[lane] = __expf(gf[0] - gmf); wsl[64 + lane] = __expf(gf[1] - gmf); wsl[128 + lane] = __expf(gb[0] - gmb); wsl[192 + lane] = __expf(gb[1] - gmb);
    LDS_FENCE();
    const bf16* krow = (const bf16*)(F.ws + WS_KCT) + (size_t)(h * 128 + 16 * w + fr) * MTOK + tok0 + 8 * fq;
    bf16x8 yf[4], yb[4]; float unf = 0.f, unb = 0.f;
#pragma unroll
    for (int ks = 0; ks < 4; ++ks) { const bf16x8 raw = *(const bf16x8*)(krow + 32 * ks);
        const f32x4 wf0 = *(const LAS f32x4*)(wsl + 32 * ks + 8 * fq), wf1 = *(const LAS f32x4*)(wsl + 32 * ks + 8 * fq + 4);
        const f32x4 wb0 = *(const LAS f32x4*)(wsl + 128 + 32 * ks + 8 * fq), wb1 = *(const LAS f32x4*)(wsl + 128 + 32 * ks + 8 * fq + 4);
        float a[8], b[8];
#pragma unroll
        for (int j = 0; j < 8; ++j) { const float kv = bf2f(raw[j]); a[j] = kv * (j < 4 ? wf0[j & 3] : wf1[j & 3]); b[j] = kv * (j < 4 ? wb0[j & 3] : wb1[j & 3]); unf += a[j]; unb += b[j]; }
        u32x4 pa, pb; pa.x = pk2(a[0], a[1]); pa.y = pk2(a[2], a[3]); pa.z = pk2(a[4], a[5]); pa.w = pk2(a[6], a[7]);
        pb.x = pk2(b[0], b[1]); pb.y = pk2(b[2], b[3]); pb.z = pk2(b[4], b[5]); pb.w = pk2(b[6], b[7]);
        yf[ks] = __builtin_bit_cast(bf16x8, pa); yb[ks] = __builtin_bit_cast(bf16x8, pb); }
    float* uf = (float*)(F.ws + WS_UT) + ((size_t)((0 * NCHUNK + posf) * 8 + h) * 128) * 128;
    float* ub = (float*)(F.ws + WS_UT) + ((size_t)((1 * NCHUNK + posb) * 8 + h) * 128) * 128;
#pragma unroll
    for (int et = 0; et < 8; ++et) {
        const bf16* vrow = (const bf16*)(F.ws + WS_MVT) + (size_t)(h * 128 + 16 * et + fr) * MTOK + tok0 + 8 * fq;
        f32x4 af = {0.f, 0.f, 0.f, 0.f}, ab = {0.f, 0.f, 0.f, 0.f};
#pragma unroll
        for (int ks = 0; ks < 4; ++ks) { const bf16x8 xf = *(const bf16x8*)(vrow + 32 * ks); af = mfma16(xf, yf[ks], af); ab = mfma16(xf, yb[ks], ab); }
#pragma unroll
        for (int r = 0; r < 4; ++r) { uf[(size_t)(16 * et + 4 * fq + r) * 128 + 16 * w + fr] = af[r]; ub[(size_t)(16 * et + 4 * fq + r) * 128 + 16 * w + fr] = ab[r]; }
    }
    unf = qsum(unf); unb = qsum(unb);
    if (fq == 0) { ((float*)(F.ws + WS_UN))[((size_t)(0 * NCHUNK + posf) * 8 + h) * 128 + 16 * w + fr] = unf; ((float*)(F.ws + WS_UN))[((size_t)(1 * NCHUNK + posb) * 8 + h) * 128 + 16 * w + fr] = unb; }
    if (w == 0 && lane == 0) { float* bg = (float*)(F.ws + WS_BLGM);
        bg[((0 * NCHUNK + posf) * 8 + h) * 2] = g.bl_f; bg[((0 * NCHUNK + posf) * 8 + h) * 2 + 1] = gmf; bg[((1 * NCHUNK + posb) * 8 + h) * 2] = g.bl_b; bg[((1 * NCHUNK + posb) * 8 + h) * 2 + 1] = gmb; }
    LDS_FENCE();
}
__device__ __forceinline__ void scan_phase(Frame& F) {
    const float* UT = (const float*)(F.ws + WS_UT); const float* UN = (const float*)(F.ws + WS_UN); const float* BG = (const float*)(F.ws + WS_BLGM);
    bf16* CT = (bf16*)(F.ws + WS_CT); float* CN = (float*)(F.ws + WS_CN); float* CM = (float*)(F.ws + WS_CM);
    const int NT = F.G * NTHR;
    for (int gid = blockIdx.x * NTHR + F.tid; gid < 65536 + 512; gid += NT) {
        if (gid < 65536) {
            const int d4 = gid & 31, e = (gid >> 5) & 127, h = (gid >> 12) & 7, dir = gid >> 15;
            const size_t base = ((size_t)(dir * NCHUNK * 8 + h) * 128 + e) * 128 + d4 * 4, pstride = (size_t)8 * 128 * 128;
            f32x4 C = {0.f, 0.f, 0.f, 0.f}; float m = 0.f;
#pragma unroll 6
            for (int pos = 0; pos < NCHUNK; ++pos) {
                u32x2 o; o.x = pk2(C[0], C[1]); o.y = pk2(C[2], C[3]); *(u32x2*)(CT + base + pos * pstride) = o;
                if (e == 0 && d4 == 0) CM[(dir * NCHUNK + pos) * 8 + h] = m;
                const float bl = BG[((dir * NCHUNK + pos) * 8 + h) * 2], gm = BG[((dir * NCHUNK + pos) * 8 + h) * 2 + 1];
                const float mn = fmaxf(bl + m, gm), dec = __expf(bl + m - mn), sc = __expf(gm - mn);
                const f32x4 u = *(const f32x4*)(UT + base + pos * pstride);
                C = C * dec + u * sc; m = mn;
            }
        } else {
            const int k = gid - 65536, d4 = k & 31, h = (k >> 5) & 7, dir = k >> 8;
            const size_t base = ((size_t)(dir * NCHUNK * 8 + h)) * 128 + d4 * 4, pstride = (size_t)8 * 128;
            f32x4 C = {0.f, 0.f, 0.f, 0.f}; float m = 0.f;
            for (int pos = 0; pos < NCHUNK; ++pos) {
                *(f32x4*)(CN + base + pos * pstride) = C;
                const float bl = BG[((dir * NCHUNK + pos) * 8 + h) * 2], gm = BG[((dir * NCHUNK + pos) * 8 + h) * 2 + 1];
                const float mn = fmaxf(bl + m, gm), dec = __expf(bl + m - mn), sc = __expf(gm - mn);
                const f32x4 u = *(const f32x4*)(UN + base + pos * pstride);
                C = C * dec + u * sc; m = mn;
            }
        }
    }
}
__device__ __forceinline__ void mlstm_out_unit(Frame& F, int l, int c, int h, LAS float* wsl) {
    const int lane = F.lane, w = F.wave, fr = lane & 15, fq = lane >> 4, tok0 = c * 128, t = 16 * w + fr;
    const int posf = (c + 2) % NCHUNK, posb = 65 - c;
    MG g; mlstm_gates((const float*)(F.ws + WS_GATES) + (size_t)tok0 * 32 + h, lane, g);
    const float mf = ((const float*)(F.ws + WS_CM))[(0 * NCHUNK + posf) * 8 + h], mb = ((const float*)(F.ws + WS_CM))[(1 * NCHUNK + posb) * 8 + h];
    float cf[2], cb[2];
#pragma unroll
    for (int x = 0; x < 2; ++x) { cf[x] = g.i_f[x] - g.b_f[x]; cb[x] = g.i_b[x] - g.b_b[x]; }
    float pm[2], sm[2];
    { const float p0 = scan_up_max(cf[0], lane), tt = __shfl(p0, 63), p1 = fmaxf(scan_up_max(cf[1], lane), tt); pm[0] = p0; pm[1] = p1;
      const float q1 = scan_down_max(cb[1], lane), uu = __shfl(q1, 0), q0 = fmaxf(scan_down_max(cb[0], lane), uu); sm[0] = q0; sm[1] = q1; }
#pragma unroll
    for (int x = 0; x < 2; ++x) { const int s = lane + 64 * x;
        const float Mf = fmaxf(pm[x], mf), Mb = fmaxf(sm[x], mb);
        wsl[s] = cf[x]; wsl[128 + s] = cb[x];
        wsl[256 + s] = -Mf; wsl[384 + s] = __expf(mf - Mf); wsl[512 + s] = __expf(-(g.b_f[x] + Mf));
        wsl[640 + s] = -Mb; wsl[768 + s] = __expf(mb - Mb); wsl[896 + s] = __expf(-(g.b_b[x] + Mb)); }
    LDS_FENCE();
    const float rowf = wsl[256 + t], a_f = wsl[384 + t], fl_f = wsl[512 + t], rowb = wsl[640 + t], a_b = wsl[768 + t], fl_b = wsl[896 + t];
    const bf16* qrow = (const bf16*)(F.ws + WS_QC) + (size_t)(tok0 + t) * 1024 + h * 128 + 8 * fq;
    bf16x8 qf[4];
#pragma unroll
    for (int ks = 0; ks < 4; ++ks) qf[ks] = *(const bf16x8*)(qrow + 32 * ks);
    bf16x8 pf[4], pb[4]; float dsf = 0.f, dsb = 0.f;
#pragma unroll
    for (int kb = 0; kb < 4; ++kb) {
        float vf[8], vb[8];
#pragma unroll
        for (int hh = 0; hh < 2; ++hh) { const int st = 2 * kb + hh;
            const bf16* krow = (const bf16*)(F.ws + WS_KC) + (size_t)(tok0 + 16 * st + fr) * 1024 + h * 128 + 8 * fq;
            f32x4 S = {0.f, 0.f, 0.f, 0.f};
#pragma unroll
            for (int ks = 0; ks < 4; ++ks) S = mfma16(*(const bf16x8*)(krow + 32 * ks), qf[ks], S);
            const f32x4 c4f = *(const LAS f32x4*)(wsl + 16 * st + 4 * fq), c4b = *(const LAS f32x4*)(wsl + 128 + 16 * st + 4 * fq);
#pragma unroll
            for (int r = 0; r < 4; ++r) { const int s = 16 * st + 4 * fq + r;
                const float ef = (s <= t) ? __expf(rowf + c4f[r]) : 0.f, eb = (s >= t) ? __expf(rowb + c4b[r]) : 0.f;
                const float p1 = S[r] * ef, p2 = S[r] * eb; vf[4 * hh + r] = p1; vb[4 * hh + r] = p2; dsf += p1; dsb += p2; } }
        u32x4 a, b; a.x = pk2(vf[0], vf[1]); a.y = pk2(vf[2], vf[3]); a.z = pk2(vf[4], vf[5]); a.w = pk2(vf[6], vf[7]);
        b.x = pk2(vb[0], vb[1]); b.y = pk2(vb[2], vb[3]); b.z = pk2(vb[4], vb[5]); b.w = pk2(vb[6], vb[7]);
        pf[kb] = __builtin_bit_cast(bf16x8, a); pb[kb] = __builtin_bit_cast(bf16x8, b);
        __builtin_amdgcn_sched_barrier(0);
    }
    dsf = qsum(dsf); dsb = qsum(dsb);
    const float* nf = (const float*)(F.ws + WS_CN) + ((size_t)(0 * NCHUNK + posf) * 8 + h) * 128; const float* nb = (const float*)(F.ws + WS_CN) + ((size_t)(1 * NCHUNK + posb) * 8 + h) * 128;
    float qnf = 0.f, qnb = 0.f;
#pragma unroll
    for (int ks = 0; ks < 4; ++ks) { const f32x4 n0 = *(const f32x4*)(nf + 32 * ks + 8 * fq), n1 = *(const f32x4*)(nf + 32 * ks + 8 * fq + 4), m0 = *(const f32x4*)(nb + 32 * ks + 8 * fq), m1 = *(const f32x4*)(nb + 32 * ks + 8 * fq + 4);
#pragma unroll
        for (int j = 0; j < 8; ++j) { const float qv = bf2f(qf[ks][j]); qnf += qv * (j < 4 ? n0[j & 3] : n1[j & 3]); qnb += qv * (j < 4 ? m0[j & 3] : m1[j & 3]); } }
    qnf = qsum(qnf); qnb = qsum(qnb);
    const float inv_f = 1.0f / fmaxf(fabsf(a_f * qnf + dsf), fl_f), inv_b = 1.0f / fmaxf(fabsf(a_b * qnb + dsb), fl_b);
    const bf16* ctf = (const bf16*)(F.ws + WS_CT) + ((size_t)((0 * NCHUNK + posf) * 8 + h) * 128) * 128;
    const bf16* ctb = (const bf16*)(F.ws + WS_CT) + ((size_t)((1 * NCHUNK + posb) * 8 + h) * 128) * 128;
    f32x4 hs[8]; float ss = 0.f;
#pragma unroll
    for (int et = 0; et < 8; ++et) {
        f32x4 af = {0.f, 0.f, 0.f, 0.f}, ab = {0.f, 0.f, 0.f, 0.f};
#pragma unroll
        for (int ks = 0; ks < 4; ++ks) { af = mfma16(*(const bf16x8*)(ctf + (size_t)(16 * et + fr) * 128 + 32 * ks + 8 * fq), qf[ks], af);
                                         ab = mfma16(*(const bf16x8*)(ctb + (size_t)(16 * et + fr) * 128 + 32 * ks + 8 * fq), qf[ks], ab); }
        af = af * a_f; ab = ab * a_b;
        const bf16* vrow = (const bf16*)(F.ws + WS_MVT) + (size_t)(h * 128 + 16 * et + fr) * MTOK + tok0 + 4 * fq;
#pragma unroll
        for (int kb = 0; kb < 4; ++kb) { const bf16x8 xf = cat8(*(const bf16x4*)(vrow + 32 * kb), *(const bf16x4*)(vrow + 32 * kb + 16));
            af = mfma16(xf, pf[kb], af); ab = mfma16(xf, pb[kb], ab); }
        hs[et] = af * inv_f + ab * inv_b;
        ss += (hs[et][0] * hs[et][0] + hs[et][1] * hs[et][1]) + (hs[et][2] * hs[et][2] + hs[et][3] * hs[et][3]);
        __builtin_amdgcn_sched_barrier(0);
    }
    ss = qsum(ss);
    const float rstd = rsqrtf(ss * (1.0f / 128.0f) + EPS);
    const float* ng = F.in[I_MNG] + (size_t)l * 1024 + h * 128;
    const bf16* orow = (const bf16*)(F.ws + WS_P) + (size_t)(tok0 + t) * DINP + PC_MO + h * 128;
    bf16* crow = (bf16*)(F.ws + WS_CAT) + (size_t)(tok0 + t) * D + 512 + h * 128;
#pragma unroll
    for (int et = 0; et < 8; ++et) { const int e = 16 * et + 4 * fq; const bf16x4 ov = *(const bf16x4*)(orow + e); const f32x4 gg = *(const f32x4*)(ng + e);
        float y[4];
#pragma unroll
        for (int r = 0; r < 4; ++r) y[r] = sigmoid_f(bf2f(ov[r])) * (hs[et][r] * rstd * gg[r]);
        *(bf16x4*)(crow + e) = pk4(y[0], y[1], y[2], y[3]); }
    LDS_FENCE();
}

__device__ __forceinline__ void sgu_unit(Frame& F, int l, int c, int g) {
    const int lane = F.lane, w = F.wave, fr = lane & 15, fq = lane >> 4, tok0 = c * 128, t = 16 * w + fr;
    const bf16* wrow = (const bf16*)(F.ws + WS_SGW) + ((size_t)(l * 4 + g) * 128 + t) * 128 + 8 * fq;
    bf16x8 yf[4];
#pragma unroll
    for (int ks = 0; ks < 4; ++ks) yf[ks] = *(const bf16x8*)(wrow + 32 * ks);
    const float bs = F.in[I_SGB][(size_t)(l * 4 + g) * 128 + t];
    const bf16* urow = (const bf16*)(F.ws + WS_P) + (size_t)(tok0 + t) * DINP + PC_U + g * 128;
    bf16* crow = (bf16*)(F.ws + WS_CAT) + (size_t)(tok0 + t) * D + g * 128;
#pragma unroll
    for (int ct = 0; ct < 8; ++ct) {
        const bf16* vrow = (const bf16*)(F.ws + WS_VNT) + (size_t)(g * 128 + 16 * ct + fr) * MTOK + tok0 + 8 * fq;
        f32x4 a = {0.f, 0.f, 0.f, 0.f};
#pragma unroll
        for (int ks = 0; ks < 4; ++ks) a = mfma16(*(const bf16x8*)(vrow + 32 * ks), yf[ks], a);
        const int cc = 16 * ct + 4 * fq; const bf16x4 uv = *(const bf16x4*)(urow + cc);
        float y[4];
#pragma unroll
        for (int r = 0; r < 4; ++r) y[r] = gelu_tanh(bf2f(uv[r])) * (a[r] + bs);
        *(bf16x4*)(crow + cc) = pk4(y[0], y[1], y[2], y[3]);
    }
}

template <bool LOC> __device__ __forceinline__ void na_part(Frame& F, const float* rpb, bf16x8 qf0, bf16x8 qf1, int h, int r, int b, int lane, float& mx_o, float& sum_o, f32x4 (&O)[4]) {
    const int fr = lane & 15, fq = lane >> 4;
    const bf16* P = (const bf16*)(F.ws + WS_P); const bf16* VT = (const bf16*)(F.ws + WS_NAVT);
    int rs = r - 4; rs = rs < 0 ? 0 : (rs > 120 ? 120 : rs);
    int kc0 = 16 * b - 8; kc0 = kc0 < 0 ? 0 : (kc0 > 32 ? 32 : kc0);
    const int qc = 16 * b + fr; int cs = qc - 8; cs = cs < 0 ? 0 : (cs > 48 ? 48 : cs);
    const int base0 = LOC ? rs * 64 + kc0 : SEQ;
    const bf16* kbase = P + (size_t)(base0 + fr) * DINP + PC_NK + h * 64 + 8 * fq;
    const float* rpbh = rpb + (h * 15 + (rs - r + 7)) * 31 + (kc0 + 4 * fq - qc + 15);
    const int kcl = kc0 + 4 * fq;
#define NA_TILE(kt, a) do { const bf16* krow_ = kbase + (size_t)(LOC ? 64 * ((kt) >> 1) + 16 * ((kt) & 1) : 16 * (kt)) * DINP; \
        a = (f32x4){0.f, 0.f, 0.f, 0.f}; a = mfma16(*(const bf16x8*)krow_, qf0, a); a = mfma16(*(const bf16x8*)(krow_ + 32), qf1, a); \
        _Pragma("unroll") for (int rr = 0; rr < 4; ++rr) { float v_ = a[rr] * 0.125f; \
            if (LOC) { const int kc_ = kcl + 16 * ((kt) & 1) + rr; const bool valid_ = kc_ >= cs && kc_ < cs + 16; \
                int o_ = 31 * ((kt) >> 1) + 16 * ((kt) & 1) + rr; const float bias_ = valid_ ? rpbh[o_] : 0.f; v_ = valid_ ? v_ + bias_ : -1e30f; } \
            a[rr] = v_; } } while (0)
    float mx = -1e30f;
#pragma unroll 2
    for (int kt = 0; kt < 16; ++kt) { f32x4 a; NA_TILE(kt, a); mx = fmaxf(fmaxf(mx, fmaxf(a[0], a[1])), fmaxf(a[2], a[3])); }
    mx = qmax(mx);
    float sum = 0.f;
#pragma unroll
    for (int dt = 0; dt < 4; ++dt) O[dt] = (f32x4){0.f, 0.f, 0.f, 0.f};
    const bf16* vbase = VT + (size_t)(h * 64 + fr) * MTOK + base0 + 4 * fq;
    for (int kb = 0; kb < 8; ++kb) {
        f32x4 a0, a1; NA_TILE(2 * kb, a0); NA_TILE(2 * kb + 1, a1);
#pragma unroll
        for (int rr = 0; rr < 4; ++rr) { a0[rr] = __expf(a0[rr] - mx); a1[rr] = __expf(a1[rr] - mx); sum += a0[rr] + a1[rr]; }
        u32x4 pp; pp.x = pk2(a0[0], a0[1]); pp.y = pk2(a0[2], a0[3]); pp.z = pk2(a1[0], a1[1]); pp.w = pk2(a1[2], a1[3]);
        const bf16x8 pfrag = __builtin_bit_cast(bf16x8, pp);
#pragma unroll
        for (int dt = 0; dt < 4; ++dt) { const bf16* vrow = vbase + (size_t)(16 * dt) * MTOK + (LOC ? 64 * kb : 32 * kb);
            O[dt] = mfma16(cat8(*(const bf16x4*)vrow, *(const bf16x4*)(vrow + 16)), pfrag, O[dt]); }
    }
#undef NA_TILE
    mx_o = mx; sum_o = qsum(sum);
}
template <bool LOCAL> __device__ __forceinline__ void na_wave(Frame& F, const float* rpb  , int tokq0, int h, int r, int b, int lane) {
    const int fr = lane & 15, fq = lane >> 4, tokq = tokq0 + fr;
    const bf16* qrow = (const bf16*)(F.ws + WS_P) + (size_t)tokq * DINP + PC_NQ + h * 64 + 8 * fq;
    const bf16x8 qf0 = *(const bf16x8*)qrow, qf1 = *(const bf16x8*)(qrow + 32);
    float m2, l2; f32x4 O2[4];
    na_part<false>(F, rpb, qf0, qf1, h, r, b, lane, m2, l2, O2);
    if (LOCAL) {
        float m1, l1; f32x4 O1[4];
        na_part<true>(F, rpb, qf0, qf1, h, r, b, lane, m1, l1, O1);
        const float M = fmaxf(m1, m2), e1 = __expf(m1 - M), e2 = __expf(m2 - M);
        l2 = l1 * e1 + l2 * e2;
#pragma unroll
        for (int dt = 0; dt < 4; ++dt) O2[dt] = O1[dt] * e1 + O2[dt] * e2;
    }
    const float inv = 1.0f / l2;
    bf16* crow = (bf16*)(F.ws + WS_CAT) + (size_t)tokq * D + 1536 + h * 64;
#pragma unroll
    for (int dt = 0; dt < 4; ++dt) *(bf16x4*)(crow + 16 * dt + 4 * fq) = pk4(O2[dt][0] * inv, O2[dt][1] * inv, O2[dt][2] * inv, O2[dt][3] * inv);
}

__global__ void __launch_bounds__(NTHR, 2) mk_fwd(Args args) {
    extern __shared__ __attribute__((aligned(16))) unsigned char lds[];
    Frame F;
    F.lds = (LAS unsigned char*)lds;
    frame_tid(F);
    F.G = gridDim.x; F.in = args.in; F.out = args.out; F.ws = args.ws;
    volatile LAS unsigned* MISC = (volatile LAS unsigned*)(F.lds + LDSCTL_OFF);
    for (int u = F.tid; u < (LDS_BYTES - LDSCTL_OFF) / 4; u += NTHR) MISC[u] = 0u;
    __syncthreads();
#if !MK_SPLIT
    (void)xcd_barrier_post((unsigned*)(args.ws + WS_CTL) + 4096, MISC + 8);
#endif
    const int lo = args.step_lo, hi = args.step_hi;
#define MODL ((const float*)(F.ws + WS_MOD) + (size_t)l * 2 * NMODV)
    int step = 0;
#define IN_STEP() (step >= lo && step < hi && (frame_site(F, args), true))
#if MK_SPLIT
#define END_STEP() do { ++step; } while (0)
#else
#define END_STEP() do { if (step >= lo && step + 1 < hi) { XcdBarrier b_; b_.bar = (unsigned*)(args.ws + WS_CTL) + 4096; b_.x = xb_xcc_id(); b_.st = MISC + 8; xcd_barrier(b_); } ++step; } while (0)
#endif

    if (IN_STEP()) p0_prologue(F);
    END_STEP();

    for (int l = 0; l < DEPTH; ++l) {
        for (int f = 0; f < 2; ++f) {
            if (IN_STEP()) norm_phase(F, F.in[I_NORMG] + (size_t)(l * 3 + 2 * f) * D, MODL, 6 * f, 6 * f + 1, MTOK);
            END_STEP();
            if (IN_STEP()) {
                pg8::Gemm g{(const bf16*)(F.ws + WS_ABUF), (const bf16*)(F.ws + WS_W13T + (size_t)(l * 2 + f) * SZ_W13T), D, D};
                pg8::StaticOrder S; S.init(MTOK, 2 * DFF, F.G, (int)blockIdx.x);
                pg8::EpiSwiGLU E{(bf16*)(F.ws + WS_HB), DFF};
                pg8::gemm_phase<pg8::EpiSwiGLU, pg8::StaticOrder, true, true>(F.lds, g, S, E);
            }
            END_STEP();
            if (IN_STEP()) {
                const float* gl = MODL + (6 * f + 2) * D; const float* gc = gl + NMODV; float* H = (float*)(F.ws + WS_H); bf16* HB = (bf16*)(F.ws + WS_HB);
                { pg8::Gemm g{HB, (const bf16*)(F.ws + WS_W2T + (size_t)(l * 2 + f) * SZ_W2T), DFF, DFF};
                  pg8::StaticOrder S; S.init(SEQ, D, F.G, (int)blockIdx.x);
                  pg8::EpiResid<false> E{H, gl, gc, 0};
                  pg8::gemm_phase<pg8::EpiResid<false>, pg8::StaticOrder, true, true>(F.lds, g, S, E); }
                { pg8::Gemm g{HB + (size_t)SEQ * DFF, (const bf16*)(F.ws + WS_W2T + (size_t)(l * 2 + f) * SZ_W2T), DFF, 256};
                  pg8::SplitKOrder S{8, DFF / 256, 256, F.G, (int)blockIdx.x};
                  pg8::EpiResid<true> E{H, gl, gc, SEQ};
                  pg8::gemm_phase<pg8::EpiResid<true>, pg8::SplitKOrder, false, false>(F.lds, g, S, E); }
            }
            END_STEP();
            if (f == 0) {
                if (IN_STEP()) norm_phase(F, F.in[I_NORMG] + (size_t)(l * 3 + 1) * D, MODL, 3, 4, MTOK);
                END_STEP();
                if (IN_STEP()) {
                    pg8::Gemm g{(const bf16*)(F.ws + WS_ABUF), (const bf16*)(F.ws + WS_WINT + (size_t)l * SZ_WINT), D, D};
                    pg8::StaticOrder S; S.init(MTOK, DINP, F.G, (int)blockIdx.x);
                    pg8::EpiWin E{(bf16*)(F.ws + WS_P), (float*)(F.ws + WS_GATES), F.in[I_GATEB] + (size_t)l * 32};
                    pg8::gemm_phase<pg8::EpiWin, pg8::StaticOrder, true, true>(F.lds, g, S, E);
                }
                END_STEP();
                if (IN_STEP()) prep_phase(F, l);
                END_STEP();
                if (IN_STEP()) {
                    LAS float* wsl = (LAS float*)(F.lds + F.wave * 16384);
                    for (int u = blockIdx.x; u < NCHUNK * 8; u += F.G) mlstm_local_unit(F, u >> 3, u & 7, wsl);
                    for (int v = ((int)blockIdx.x + F.G - (NCHUNK * 8) % F.G) % F.G; v < NCHUNK * 4; v += F.G) sgu_unit(F, l, v >> 2, v & 3);
                }
                END_STEP();
                if (IN_STEP()) scan_phase(F);
                END_STEP();
                if (IN_STEP()) {
                    const float* rpb = F.in[I_RPB] + (size_t)l * 8 * 15 * 31;
                    LAS float* wsl = (LAS float*)(F.lds + F.wave * 16384);
                    for (int u = blockIdx.x; u < NCHUNK * 8; u += F.G) mlstm_out_unit(F, l, u >> 3, u & 7, wsl);
                    for (int v = ((int)blockIdx.x + F.G - (NCHUNK * 8) % F.G) % F.G; v < 512; v += F.G) { const int r = v >> 2, hp = v & 3;
                        na_wave<true>(F, rpb, r * 64 + 16 * (F.wave & 3), 2 * hp + (F.wave >> 2), r, F.wave & 3, F.lane); }
                    for (int v = ((int)blockIdx.x + F.G - (NCHUNK * 8 + 512) % F.G) % F.G; v < 16; v += F.G) { const int wi = v * 8 + F.wave;
                        na_wave<false>(F, rpb, SEQ + 16 * (wi >> 3), wi & 7, 0, 0, F.lane); }
                }
                END_STEP();
                if (IN_STEP()) {
                    const float* gl = MODL + 5 * D; const float* gc = gl + NMODV; float* H = (float*)(F.ws + WS_H); bf16* CAT = (bf16*)(F.ws + WS_CAT);
                    { pg8::Gemm g{CAT, (const bf16*)(F.ws + WS_WOUTT + (size_t)l * SZ_WOUTT), D, D};
                      pg8::StaticOrder S; S.init(SEQ, D, F.G, (int)blockIdx.x);
                      pg8::EpiResid<false> E{H, gl, gc, 0};
                      pg8::gemm_phase<pg8::EpiResid<false>, pg8::StaticOrder, true, true>(F.lds, g, S, E); }
                    { pg8::Gemm g{CAT + (size_t)SEQ * D, (const bf16*)(F.ws + WS_WOUTT + (size_t)l * SZ_WOUTT), D, 256};
                      pg8::SplitKOrder S{8, D / 256, 256, F.G, (int)blockIdx.x};
                      pg8::EpiResid<true> E{H, gl, gc, SEQ};
                      pg8::gemm_phase<pg8::EpiResid<true>, pg8::SplitKOrder, false, false>(F.lds, g, S, E); }
                }
                END_STEP();
            }
        }
    }
    if (IN_STEP()) final_norm_phase(F);
#undef MODL
#undef IN_STEP
#undef END_STEP
}
constexpr int N_STEPS = 1 + DEPTH * 13 + 1;

extern "C" void kernel_launch(void* const* d_in, const int* in_sizes, int n_in, void* d_out, int out_size, void* d_ws, size_t ws_size, hipStream_t stream) {
    static int grid = 0;
    if (grid == 0) {
        if (n_in != 22 || out_size != SEQ * D || ws_size < WS_END) { fprintf(stderr, "kernel_launch: unexpected shapes (n_in %d, out %d, ws %zu < %zu)\n", n_in, out_size, ws_size, (size_t)WS_END); grid = -1; return; }
        int dev = 0, cus = 0, per_cu = 0;
        if (hipGetDevice(&dev) != hipSuccess || hipDeviceGetAttribute(&cus, hipDeviceAttributeMultiprocessorCount, dev) != hipSuccess) { grid = -1; return; }
        if (hipFuncSetAttribute((const void*)mk_fwd, hipFuncAttributeMaxDynamicSharedMemorySize, LDS_BYTES) != hipSuccess) { fprintf(stderr, "kernel_launch: hipFuncSetAttribute failed\n"); grid = -1; return; }
        if (hipOccupancyMaxActiveBlocksPerMultiprocessor(&per_cu, (const void*)mk_fwd, NTHR, LDS_BYTES) != hipSuccess || per_cu < 1) fprintf(stderr, "kernel_launch: occupancy query says %d\n", per_cu);
        (void)hipGetLastError();
        grid = cus;
    }
    if (grid < 0) return;
    (void)hipMemsetAsync((char*)d_ws + WS_CTL, 0, CTL_ZERO_BYTES, stream);
    Args a{};
    for (int i = 0; i < 22; ++i) a.in[i] = (const float*)d_in[i];
    a.out = (float*)d_out; a.ws = (unsigned char*)d_ws;
#if MK_SPLIT
    for (int s = 0; s < N_STEPS; ++s) { a.step_lo = s; a.step_hi = s + 1; hipLaunchKernelGGL(mk_fwd, dim3(grid), dim3(NTHR), LDS_BYTES, stream, a); }
#else
    a.step_lo = 0; a.step_hi = N_STEPS;
    hipLaunchKernelGGL(mk_fwd, dim3(grid), dim3(NTHR), LDS_BYTES, stream, a);
#endif
    const hipError_t le = hipPeekAtLastError();
    if (le != hipSuccess) fprintf(stderr, "kernel_launch: launch failed: %s\n", hipGetErrorName(le));
}
```

```cpp
#include <hip/hip_runtime.h>
#include <cstdio>
#include <cstdint>

#ifndef MK_SPLIT
#define MK_SPLIT 0
#endif

#ifndef REP_PRO
#define REP_PRO 1
#endif
#ifndef REP_NORM
#define REP_NORM 1
#endif
#ifndef REP_G1
#define REP_G1 1
#endif
#ifndef REP_G3
#define REP_G3 1
#endif
#ifndef REP_PREP
#define REP_PREP 1
#endif
#ifndef REP_LOC
#define REP_LOC 1
#endif
#ifndef REP_SCAN
#define REP_SCAN 1
#endif
#ifndef REP_OUT
#define REP_OUT 1
#endif
#define GAS __attribute__((address_space(1)))
#define LAS __attribute__((address_space(3)))

namespace pg8 {
#define PG8_LAS __attribute__((address_space(3)))
typedef unsigned short bf16_t;
typedef short bf16x8 __attribute__((ext_vector_type(8)));
typedef float f32x4 __attribute__((ext_vector_type(4)));
typedef unsigned u32x4 __attribute__((ext_vector_type(4)));
constexpr int BM = 256, BK = 64, HALF = 128, HTB = HALF * BK * 2  , STAGE_BYTES = 8 * HTB, NXCD = 8, WGM = 8;

__host__ __device__ __forceinline__ int lds_byte(int r, int c) { const int st = (r >> 4) * 2 + (c >> 5), rr = r & 15, cc = c & 31, ob = rr * 64 + cc * 2; return st * 1024 + (ob ^ (((ob >> 9) & 1) << 5)); }
__host__ __device__ __forceinline__ void stage_rc(int b, int& R, int& C) { const int st = b / 1024, sb = b % 1024, swz = sb ^ (((sb >> 9) & 1) << 5); R = (st >> 1) * 16 + swz / 64; C = (st & 1) * 32 + (swz % 64) / 2; }
__host__ __device__ __forceinline__ int perm32(int rho) { const int n = rho >> 4, i = rho & 15; return 8 * (i >> 2) + 4 * n + (i & 3); }

struct Unit { int pm, pn, koff; };
struct Gemm { const bf16_t* A; const bf16_t* Bt; int ld, K; };

struct StaticOrder {
    int nM, nN, nwg, G, c;
    __host__ __device__ void init(int M, int N, int G_, int c_) { nM = M / BM; nN = N / BM; nwg = nM * nN; G = G_; c = c_; }
    __host__ __device__ bool next(int i, Unit& u) const {
        const long L = (long)i * G + c; if (L >= nwg) return false;
        int wgid = (int)L; { const int q = nwg / NXCD, r = nwg % NXCD, xcd = wgid % NXCD, off = wgid / NXCD; wgid = (xcd < r ? xcd * (q + 1) : r * (q + 1) + (xcd - r) * q) + off; }
        const int nig = WGM * nN, gid = wgid / nig, fm = gid * WGM, gsz = (nM - fm) < WGM ? (nM - fm) : WGM;
        u.pm = fm + ((wgid % nig) % gsz); u.pn = (wgid % nig) / gsz; u.koff = 0; return true;
    }
    __device__ __forceinline__ void a_ready(const Unit&) const {}
    __device__ __forceinline__ void done(const Unit&) const {}
};
struct SplitKOrder {
    int nN, nK, kslice, G, c;
    __host__ __device__ bool next(int i, Unit& u) const {
        const long L = (long)i * G + c; if (L >= (long)nN * nK) return false;
        u.pm = 0; u.pn = (int)(L % nN); u.koff = (int)(L / nN) * kslice; return true;
    }
    __device__ __forceinline__ void a_ready(const Unit&) const {}
    __device__ __forceinline__ void done(const Unit&) const {}
};

__device__ __forceinline__ unsigned cvt_pk_bf16(float lo, float hi) { unsigned r; asm volatile("v_cvt_pk_bf16_f32 %0, %1, %2" : "=v"(r) : "v"(lo), "v"(hi)); return r; }
__device__ __forceinline__ float silu_f(float a) { return a * __builtin_amdgcn_rcpf(1.0f + __expf(-a)); }

struct EpiSwiGLU {
    static constexpr bool PERM = true, AFTER_DRAIN = false;
    bf16_t* O; int ldc;
    __device__ __forceinline__ void operator()(const f32x4 (&acc)[2][2][4][2], const Unit& u, int wr, int wc, int fr, int fq) const {
        const int row0 = u.pm * BM + wr * 64 + fr, col0 = u.pn * HALF + wc * 32 + 8 * fq;
#pragma unroll
        for (int ai = 0; ai < 2; ++ai)
#pragma unroll
            for (int m = 0; m < 4; ++m) { bf16_t* rowp = O + (size_t)(row0 + ai * HALF + m * 16) * ldc + col0;
                const f32x4 a0 = acc[ai][0][m][0], a1 = acc[ai][0][m][1], g0 = acc[ai][1][m][0], g1 = acc[ai][1][m][1];
                u32x4 w; w.x = cvt_pk_bf16(silu_f(a0[0]) * g0[0], silu_f(a0[1]) * g0[1]); w.y = cvt_pk_bf16(silu_f(a0[2]) * g0[2], silu_f(a0[3]) * g0[3]);
                w.z = cvt_pk_bf16(silu_f(a1[0]) * g1[0], silu_f(a1[1]) * g1[1]); w.w = cvt_pk_bf16(silu_f(a1[2]) * g1[2], silu_f(a1[3]) * g1[3]);
                *(u32x4*)rowp = w; }
    }
};
struct EpiResid {
    static constexpr bool PERM = false, AFTER_DRAIN = false;
    float* H; const float* gate;
    __device__ __forceinline__ void operator()(const f32x4 (&acc)[2][2][4][2], const Unit& u, int wr, int wc, int fr, int fq) const {
        const int row0 = u.pm * BM + wr * 64 + fr, col0 = u.pn * BM + wc * 32 + 4 * fq;
        f32x4 gv[2][2];
#pragma unroll
        for (int bj = 0; bj < 2; ++bj)
#pragma unroll
            for (int n = 0; n < 2; ++n) gv[bj][n] = *(const f32x4*)(gate + col0 + bj * HALF + n * 16);
#pragma unroll
        for (int ai = 0; ai < 2; ++ai)
#pragma unroll
            for (int m = 0; m < 4; ++m) { float* rowp = H + (size_t)(row0 + ai * HALF + m * 16) * 2048 + col0;
#pragma unroll
                for (int bj = 0; bj < 2; ++bj)
#pragma unroll
                    for (int n = 0; n < 2; ++n) { float* p = rowp + bj * HALF + n * 16; *(f32x4*)p = *(const f32x4*)p + gv[bj][n] * acc[ai][bj][m][n]; }
                asm volatile("" ::: "memory"); }
    }
};
struct EpiSlab {
    static constexpr bool PERM = false, AFTER_DRAIN = false;
    float* SLAB; const float* gate; int kslice;
    __device__ __forceinline__ void operator()(const f32x4 (&acc)[2][2][4][2], const Unit& u, int wr, int wc, int fr, int fq) const {
        const int row0 = wr * 64 + fr, col0 = u.pn * BM + wc * 32 + 4 * fq;
        float* base = SLAB + (size_t)(u.koff / kslice) * 256 * 2048;
        f32x4 gv[2][2];
#pragma unroll
        for (int bj = 0; bj < 2; ++bj)
#pragma unroll
            for (int n = 0; n < 2; ++n) gv[bj][n] = *(const f32x4*)(gate + col0 + bj * HALF + n * 16);
#pragma unroll
        for (int ai = 0; ai < 2; ++ai)
#pragma unroll
            for (int m = 0; m < 4; ++m) { float* rowp = base + (size_t)(row0 + ai * HALF + m * 16) * 2048 + col0;
#pragma unroll
                for (int bj = 0; bj < 2; ++bj)
#pragma unroll
                    for (int n = 0; n < 2; ++n) *(f32x4*)(rowp + bj * HALF + n * 16) = gv[bj][n] * acc[ai][bj][m][n]; }
    }
};
struct EpiWin {
    static constexpr bool PERM = true, AFTER_DRAIN = false;
    bf16_t* P; float* GATES; const float* gate_b;
    __device__ __forceinline__ void operator()(const f32x4 (&acc)[2][2][4][2], const Unit& u, int wr, int wc, int fr, int fq) const {
        const int row0 = u.pm * BM + wr * 64 + fr;
        if (u.pn < 26) {
            const int col0 = u.pn * BM + wc * 32 + 8 * fq;
#pragma unroll
            for (int ai = 0; ai < 2; ++ai)
#pragma unroll
                for (int m = 0; m < 4; ++m) { bf16_t* rowp = P + (size_t)(row0 + ai * HALF + m * 16) * 6912 + col0;
#pragma unroll
                    for (int bj = 0; bj < 2; ++bj) { const f32x4 v0 = acc[ai][bj][m][0], v1 = acc[ai][bj][m][1];
                        u32x4 w; w.x = cvt_pk_bf16(v0[0], v0[1]); w.y = cvt_pk_bf16(v0[2], v0[3]); w.z = cvt_pk_bf16(v1[0], v1[1]); w.w = cvt_pk_bf16(v1[2], v1[3]);
                        *(u32x4*)(rowp + bj * HALF) = w; } }
        } else if (wc == 0) {
            const f32x4 b0 = *(const f32x4*)(gate_b + 8 * fq), b1 = *(const f32x4*)(gate_b + 8 * fq + 4);
#pragma unroll
            for (int ai = 0; ai < 2; ++ai)
#pragma unroll
                for (int m = 0; m < 4; ++m) { float* rowp = GATES + (size_t)(row0 + ai * HALF + m * 16) * 32 + 8 * fq;
                    *(f32x4*)rowp = acc[ai][0][m][0] + b0; *(f32x4*)(rowp + 4) = acc[ai][0][m][1] + b1; }
        }
    }
};

template <class Epi, class Sched, bool ALIGN_EPI = false, bool SP2 = false>
__device__ __forceinline__ void gemm_phase(PG8_LAS unsigned char* lds, const Gemm g, const Sched& S, const Epi& E) {
    int tid_ = threadIdx.x; asm volatile("" : "+v"(tid_));
    const int tid = tid_, wid = __builtin_amdgcn_readfirstlane(tid >> 6), lane = tid & 63, wr = wid >> 2, wc = wid & 3, fr = lane & 15, fq = lane >> 4;
    const int ld = g.ld; int nt = g.K / BK; asm volatile("" : "+s"(nt));
    unsigned voffA[2], voffB[2];
#pragma unroll
    for (int i = 0; i < 2; ++i) { int R, C; stage_rc(tid * 16 + i * 8192, R, C); const int Rb = Epi::PERM ? ((R & ~31) + perm32(R & 31)) : R;
        voffA[i] = (unsigned)(R * ld + C) * 2u; voffB[i] = (unsigned)(Rb * ld + C) * 2u; }
    const size_t kstep = (size_t)(BK * 2);
    const size_t hstep = (size_t)HALF * ld * 2;
    const size_t tstep = 2 * hstep;
    const unsigned ldsw = (unsigned)wid * 1024u;
    const int aoff = lds_byte(wr * 64 + fr, fq * 8), boff = lds_byte(wc * 32 + fr, fq * 8);
#define PG8_SA(b, h) (((b) * 2 + (h)) * HTB)
#define PG8_SB(b, h) ((4 + (b) * 2 + (h)) * HTB)
#define PG8_STAGE(bufoff, gbase, voff) do { _Pragma("unroll") for (int _i = 0; _i < 2; ++_i) \
        __builtin_amdgcn_global_load_lds((const unsigned*)((const char*)(gbase) + (voff)[_i]), (PG8_LAS unsigned*)(lds + (bufoff) + ldsw + _i * 8192), 16, 0, 0); } while (0)
#define PG8_LDA(dst, b, h) do { _Pragma("unroll") for (int m = 0; m < 4; ++m) _Pragma("unroll") for (int k = 0; k < 2; ++k) dst[m][k] = *(const PG8_LAS bf16x8*)(lds + PG8_SA(b, h) + aoff + m * 2048 + k * 1024); } while (0)
#define PG8_LDB(dst, b, h) do { _Pragma("unroll") for (int n = 0; n < 2; ++n) _Pragma("unroll") for (int k = 0; k < 2; ++k) dst[n][k] = *(const PG8_LAS bf16x8*)(lds + PG8_SB(b, h) + boff + n * 2048 + k * 1024); } while (0)
#define PG8_MMA(ai, bj, At, Bt) do { __builtin_amdgcn_s_setprio(1); _Pragma("unroll") for (int m = 0; m < 4; ++m) _Pragma("unroll") for (int n = 0; n < 2; ++n) _Pragma("unroll") for (int k = 0; k < 2; ++k) \
        acc[ai][bj][m][n] = __builtin_amdgcn_mfma_f32_16x16x32_bf16(Bt[n][k], At[m][k], acc[ai][bj][m][n], 0, 0, 0); __builtin_amdgcn_s_setprio(0); } while (0)
#define PG8_WAIT_V(n) asm volatile("s_waitcnt vmcnt(" #n ")" ::: "memory")
#define PG8_WAIT_L(n) asm volatile("s_waitcnt lgkmcnt(" #n ")" ::: "memory")
#define PG8_BAR __builtin_amdgcn_s_barrier()
#define PG8_SCHED __builtin_amdgcn_sched_barrier(0)
    Unit cur, nxt; int ui = 0;
    if (!S.next(0, cur)) return;
    f32x4 acc[2][2][4][2];
#pragma unroll
    for (int a = 0; a < 2; ++a)
#pragma unroll
        for (int b = 0; b < 2; ++b)
#pragma unroll
            for (int m = 0; m < 4; ++m)
#pragma unroll
                for (int n = 0; n < 2; ++n) acc[a][b][m][n] = (f32x4){0.f, 0.f, 0.f, 0.f};
    bf16x8 At[4][2], B0[2][2], B1[2][2];
    const char* cA = (const char*)g.A + (size_t)cur.pm * tstep + (size_t)cur.koff * 2; const char* cB = (const char*)g.Bt + (size_t)cur.pn * tstep + (size_t)cur.koff * 2;
    S.a_ready(cur);
    if constexpr (SP2) {
        PG8_STAGE(PG8_SB(0, 0), cB, voffB); PG8_STAGE(PG8_SB(0, 1), cB + hstep, voffB); PG8_STAGE(PG8_SA(0, 0), cA, voffA); PG8_STAGE(PG8_SA(0, 1), cA + hstep, voffA);
        if (wr == 1) PG8_BAR;
        PG8_WAIT_V(2); PG8_BAR;
        PG8_STAGE(PG8_SB(1, 0), cB + kstep, voffB); PG8_STAGE(PG8_SA(1, 0), cA + kstep, voffA); PG8_STAGE(PG8_SB(1, 1), cB + hstep + kstep, voffB);
        PG8_WAIT_V(6); PG8_BAR;
    } else {
        PG8_STAGE(PG8_SB(0, 0), cB, voffB); PG8_STAGE(PG8_SA(0, 0), cA, voffA); PG8_STAGE(PG8_SB(0, 1), cB + hstep, voffB); PG8_STAGE(PG8_SA(0, 1), cA + hstep, voffA);
        if (wr == 1) PG8_BAR;
        PG8_WAIT_V(4); PG8_BAR;
        PG8_STAGE(PG8_SB(1, 0), cB + kstep, voffB); PG8_STAGE(PG8_SA(1, 0), cA + kstep, voffA); PG8_STAGE(PG8_SB(1, 1), cB + hstep + kstep, voffB);
        PG8_WAIT_V(6); PG8_BAR;
    }
    for (;;) {
        const bool has_next = S.next(ui + 1, nxt);
        const char* nA = has_next ? (const char*)g.A + (size_t)nxt.pm * tstep + (size_t)nxt.koff * 2 : cA; const char* nB = has_next ? (const char*)g.Bt + (size_t)nxt.pn * tstep + (size_t)nxt.koff * 2 : cB;
        for (int t = 0; t < nt; t += 2) {
            const bool last = (t == nt - 2);
            const char* a1 = cA + (size_t)(t + 1) * kstep;
            const char* a2 = last ? nA : cA + (size_t)(t + 2) * kstep; const char* b2 = last ? nB : cB + (size_t)(t + 2) * kstep;
            const char* a3 = a2 + kstep; const char* b3 = b2 + kstep;
            if (last && has_next) S.a_ready(nxt);
            if constexpr (SP2) {
            PG8_LDB(B0, 0, 0); PG8_LDB(B1, 0, 1); PG8_SCHED; PG8_LDA(At, 0, 0); PG8_STAGE(PG8_SA(1, 1), a1 + hstep, voffA);
            PG8_WAIT_V(8); PG8_WAIT_L(0); PG8_BAR; PG8_MMA(0, 0, At, B0); PG8_MMA(0, 1, At, B1); PG8_BAR; PG8_SCHED;
            PG8_LDA(At, 0, 1); PG8_STAGE(PG8_SB(0, 0), b2, voffB); PG8_STAGE(PG8_SB(0, 1), b2 + hstep, voffB); PG8_STAGE(PG8_SA(0, 0), a2, voffA);
            PG8_WAIT_V(8); PG8_WAIT_L(0); PG8_BAR; PG8_MMA(1, 0, At, B0); PG8_MMA(1, 1, At, B1); PG8_BAR; PG8_SCHED;
            PG8_LDB(B0, 1, 0); PG8_LDB(B1, 1, 1); PG8_SCHED; PG8_LDA(At, 1, 0); PG8_STAGE(PG8_SA(0, 1), a2 + hstep, voffA);
            PG8_WAIT_V(8); PG8_WAIT_L(0); PG8_BAR; PG8_MMA(0, 0, At, B0); PG8_MMA(0, 1, At, B1); PG8_BAR; PG8_SCHED;
            PG8_LDA(At, 1, 1); PG8_STAGE(PG8_SB(1, 0), b3, voffB); PG8_STAGE(PG8_SB(1, 1), b3 + hstep, voffB); PG8_STAGE(PG8_SA(1, 0), a3, voffA);
            PG8_WAIT_V(8); PG8_WAIT_L(0); PG8_BAR; PG8_MMA(1, 0, At, B0); PG8_MMA(1, 1, At, B1); PG8_BAR; PG8_SCHED;
            } else {
            PG8_LDB(B0, 0, 0); PG8_SCHED; PG8_LDA(At, 0, 0); PG8_STAGE(PG8_SA(1, 1), a1 + hstep, voffA);
            PG8_WAIT_L(8); PG8_BAR; PG8_WAIT_L(0); PG8_MMA(0, 0, At, B0); PG8_BAR; PG8_SCHED;
            PG8_LDB(B1, 0, 1); PG8_STAGE(PG8_SB(0, 0), b2, voffB);
            PG8_BAR; PG8_WAIT_L(0); PG8_MMA(0, 1, At, B1); PG8_BAR;
            PG8_LDA(At, 0, 1); PG8_STAGE(PG8_SA(0, 0), a2, voffA);
            PG8_BAR; PG8_WAIT_L(0); PG8_MMA(1, 0, At, B0); PG8_BAR; PG8_SCHED;
            PG8_STAGE(PG8_SB(0, 1), b2 + hstep, voffB);
            PG8_WAIT_V(6); PG8_BAR; PG8_MMA(1, 1, At, B1); PG8_BAR;
            PG8_LDB(B0, 1, 0); PG8_SCHED; PG8_LDA(At, 1, 0); PG8_STAGE(PG8_SA(0, 1), a2 + hstep, voffA);
            PG8_WAIT_L(8); PG8_BAR; PG8_WAIT_L(0); PG8_MMA(0, 0, At, B0); PG8_BAR; PG8_SCHED;
            PG8_LDB(B1, 1, 1); PG8_STAGE(PG8_SB(1, 0), b3, voffB);
            PG8_BAR; PG8_WAIT_L(0); PG8_MMA(0, 1, At, B1); PG8_BAR;
            PG8_LDA(At, 1, 1); PG8_STAGE(PG8_SA(1, 0), a3, voffA);
            PG8_BAR; PG8_WAIT_L(0); PG8_MMA(1, 0, At, B0); PG8_BAR; PG8_SCHED;
            PG8_STAGE(PG8_SB(1, 1), b3 + hstep, voffB);
            PG8_WAIT_V(6); PG8_BAR; PG8_MMA(1, 1, At, B1); PG8_BAR;
            }
        }
        if constexpr (ALIGN_EPI) { if (wr == 0) PG8_BAR; }
        if constexpr (!Epi::AFTER_DRAIN) { E(acc, cur, wr, wc, fr, fq); S.done(cur); }
        if (!has_next) break;
#pragma unroll
        for (int a = 0; a < 2; ++a)
#pragma unroll
            for (int b = 0; b < 2; ++b)
#pragma unroll
                for (int m = 0; m < 4; ++m)
#pragma unroll
                    for (int n = 0; n < 2; ++n) acc[a][b][m][n] = (f32x4){0.f, 0.f, 0.f, 0.f};
        cur = nxt; cA = nA; cB = nB; ++ui;
        if constexpr (ALIGN_EPI) { if (wr == 1) PG8_BAR; }
    }
    PG8_WAIT_V(0);
    if constexpr (!ALIGN_EPI) { if (wr == 0) PG8_BAR; }
    PG8_BAR;
#undef PG8_SA
#undef PG8_SB
#undef PG8_STAGE
#undef PG8_LDA
#undef PG8_LDB
#undef PG8_MMA
#undef PG8_WAIT_V
#undef PG8_WAIT_L
#undef PG8_BAR
#undef PG8_SCHED
}
}

constexpr int D = 2048, SEQ = 8192, CTXL = 256, MTOK = SEQ + CTXL, DEPTH = 4, DFF = 5632, NMODV = 9 * D;
constexpr int DIN = 6688, DINP = 6912;
constexpr int NCHUNK = 66;
constexpr float EPS = 1e-6f;
constexpr int NWAVES = 8, NTHR = 512;
constexpr int PC_U = 0, PC_V = 512, PC_MQ = 1024, PC_MK = 2048, PC_MV = 3072, PC_MO = 4096, PC_NQ = 5120, PC_NK = 5632, PC_NV = 6144;

constexpr size_t MiB = 1u << 20;
constexpr size_t WS_CTL = 0, CTL_ZERO_BYTES = 1 * MiB;
constexpr size_t WS_MOD = 1 * MiB;
constexpr size_t WS_ROPE = 2 * MiB;
constexpr size_t WS_SGW = 3 * MiB;
constexpr size_t SZ_W13T = (size_t)2 * DFF * D * 2, SZ_W2T = (size_t)D * DFF * 2, SZ_WINT = (size_t)DINP * D * 2, SZ_WOUTT = (size_t)D * D * 2;
constexpr size_t WS_W13T = 4 * MiB;
constexpr size_t WS_W2T = WS_W13T + 8 * SZ_W13T;
constexpr size_t WS_WINT = WS_W2T + 8 * SZ_W2T;
constexpr size_t WS_WOUTT = WS_WINT + 4 * SZ_WINT;
constexpr size_t WS_H = WS_WOUTT + 4 * SZ_WOUTT;
constexpr size_t WS_ABUF = WS_H + (size_t)MTOK * D * 4;
constexpr size_t WS_CAT = WS_ABUF + (size_t)MTOK * D * 2;
constexpr size_t WS_HB = WS_CAT + (size_t)MTOK * D * 2;
constexpr size_t WS_P = WS_HB + (size_t)MTOK * DFF * 2;
constexpr size_t WS_GATES = WS_P + (size_t)MTOK * DINP * 2;
constexpr size_t WS_QC = WS_GATES + (size_t)MTOK * 32 * 4;
constexpr size_t WS_KC = WS_QC + (size_t)MTOK * 1024 * 2;
constexpr size_t WS_KCT = WS_KC + (size_t)MTOK * 1024 * 2;
constexpr size_t WS_MVT = WS_KCT + (size_t)MTOK * 1024 * 2;
constexpr size_t WS_NAVT = WS_MVT + (size_t)MTOK * 1024 * 2;
constexpr size_t WS_VNT = WS_NAVT + (size_t)MTOK * 512 * 2;
constexpr size_t WS_UT = WS_VNT + (size_t)MTOK * 512 * 2;
constexpr size_t WS_UN = WS_UT + (size_t)2 * NCHUNK * 8 * 128 * 128 * 4;
constexpr size_t WS_BLGM = WS_UN + (size_t)2 * NCHUNK * 8 * 128 * 4;
constexpr size_t WS_CT = WS_BLGM + 1 * MiB;
constexpr size_t WS_CN = WS_CT + (size_t)2 * NCHUNK * 8 * 128 * 128 * 2;
constexpr size_t WS_CM = WS_CN + (size_t)2 * NCHUNK * 8 * 128 * 4;
constexpr size_t WS_SLAB = WS_CM + 1 * MiB;
constexpr size_t WS_END = WS_SLAB + (size_t)11 * 256 * 2048 * 4;

constexpr int RING_BYTES = 131072, LDSCTL_OFF = RING_BYTES, LDS_BYTES = 147456;

typedef unsigned short bf16;
typedef short bf16x8 __attribute__((ext_vector_type(8)));
typedef short bf16x4 __attribute__((ext_vector_type(4)));
typedef float f32x4 __attribute__((ext_vector_type(4)));
typedef float f32x2 __attribute__((ext_vector_type(2)));
typedef unsigned u32x4 __attribute__((ext_vector_type(4)));
typedef unsigned u32x2 __attribute__((ext_vector_type(2)));
typedef __bf16 bf16x2_t __attribute__((ext_vector_type(2)));
typedef GAS unsigned gu32;
#define RLX_AGENT __ATOMIC_RELAXED, __HIP_MEMORY_SCOPE_AGENT
#define LDS_FENCE() asm volatile("s_waitcnt lgkmcnt(0)" ::: "memory")

__device__ __forceinline__ float bf2f(short b) { return __uint_as_float(((unsigned)(unsigned short)b) << 16); }
__device__ __forceinline__ unsigned pk2(float lo, float hi) { f32x2 v = {lo, hi}; bf16x2_t b = __builtin_convertvector(v, bf16x2_t); return __builtin_bit_cast(unsigned, b); }
__device__ __forceinline__ short f2bf(float f) { return (short)(pk2(f, 0.f) & 0xffffu); }
__device__ __forceinline__ bf16x4 pk4(float a, float b, float c, float d) { u32x2 w; w.x = pk2(a, b); w.y = pk2(c, d); return __builtin_bit_cast(bf16x4, w); }
__device__ __forceinline__ bf16x8 cat8(bf16x4 lo, bf16x4 hi) { return __builtin_shufflevector(lo, hi, 0, 1, 2, 3, 4, 5, 6, 7); }
__device__ __forceinline__ f32x4 mfma16(bf16x8 a, bf16x8 b, f32x4 c) { return __builtin_amdgcn_mfma_f32_16x16x32_bf16(a, b, c, 0, 0, 0); }
__device__ __forceinline__ float wsum(float v) {
#pragma unroll
    for (int o = 1; o < 64; o <<= 1) v += __shfl_xor(v, o);
    return v; }
__device__ __forceinline__ float wmax(float v) {
#pragma unroll
    for (int o = 1; o < 64; o <<= 1) v = fmaxf(v, __shfl_xor(v, o));
    return v; }
__device__ __forceinline__ float qsum(float v) { v += __shfl_xor(v, 16); v += __shfl_xor(v, 32); return v; }
__device__ __forceinline__ float qmax(float v) { v = fmaxf(v, __shfl_xor(v, 16)); v = fmaxf(v, __shfl_xor(v, 32)); return v; }
__device__ __forceinline__ float scan_up_add(float v, int lane) {
#pragma unroll
    for (int o = 1; o < 64; o <<= 1) { const float t = __shfl_up(v, o); if (lane >= o) v += t; }
    return v; }
__device__ __forceinline__ float scan_down_add(float v, int lane) {
#pragma unroll
    for (int o = 1; o < 64; o <<= 1) { const float t = __shfl_down(v, o); if (lane + o < 64) v += t; }
    return v; }
__device__ __forceinline__ float scan_up_max(float v, int lane) {
#pragma unroll
    for (int o = 1; o < 64; o <<= 1) { const float t = __shfl_up(v, o); if (lane >= o) v = fmaxf(v, t); }
    return v; }
__device__ __forceinline__ float scan_down_max(float v, int lane) {
#pragma unroll
    for (int o = 1; o < 64; o <<= 1) { const float t = __shfl_down(v, o); if (lane + o < 64) v = fmaxf(v, t); }
    return v; }
__device__ __forceinline__ float sigmoid_f(float a) { return __builtin_amdgcn_rcpf(1.0f + __expf(-a)); }
__device__ __forceinline__ float silu_f(float a) { return a * sigmoid_f(a); }
__device__ __forceinline__ float gelu_tanh(float x) { const float u = 1.5957691216057308f * (x + 0.044715f * x * x * x); return x * sigmoid_f(u); }
__device__ __forceinline__ float logsig(float x) { return fminf(x, 0.f) - log1pf(__expf(-fabsf(x))); }

#define XB_TMO      128
#define XB_XCNT(j)  (256  + 64 * (j))
#define XB_XSUB(j)  (1280 + 64 * (j))
#define XB_XGEN(j)  (2304 + 64 * (j))
#define XB_TOP      3328
#define XB_TOPGEN   3392
#define XCD_BAR_WORDS 3456
#define XB_SPIN_CAP (1u << 20)
__device__ __forceinline__ unsigned xb_ld(unsigned* p)              { return __hip_atomic_load(p, __ATOMIC_RELAXED, __HIP_MEMORY_SCOPE_AGENT); }
__device__ __forceinline__ unsigned xb_add(unsigned* p, unsigned v) { return __hip_atomic_fetch_add(p, v, __ATOMIC_RELAXED, __HIP_MEMORY_SCOPE_AGENT); }
__device__ __forceinline__ unsigned xb_xcc_id() { return (unsigned)__builtin_amdgcn_s_getreg((3 << 11) | 20) & 0xFu; }
#define XB_SPIN(cond, bar) do { unsigned _sp = 0; while (cond) { __builtin_amdgcn_s_sleep(1); \
    if ((++_sp & 255u) == 0u) { if (xb_ld(&(bar)[XB_TMO])) break; if (_sp > XB_SPIN_CAP) { atomicAdd(&(bar)[XB_TMO], 1u); break; } } } } while (0)
struct XcdBarrier { unsigned* bar; unsigned x; volatile LAS unsigned* st; };
__device__ __forceinline__ XcdBarrier xcd_barrier_post(unsigned* bar, volatile LAS unsigned* st) {
    XcdBarrier b; b.bar = bar; b.x = xb_xcc_id(); b.st = st;
    if (threadIdx.x == 0) (void)xb_add(&bar[XB_XCNT(b.x)], 1u);
    return b;
}
__device__ __forceinline__ void xcd_barrier_complete(unsigned* bar, unsigned x, unsigned& nloc, unsigned& nx) {
    const unsigned G = gridDim.x * gridDim.y * gridDim.z;
    unsigned sum, cnt, mine, sp = 0u;
    for (;;) {
        sum = 0u; cnt = 0u; mine = 0u;
#pragma unroll
        for (unsigned j = 0; j < 16; ++j) { const unsigned c = xb_ld(&bar[XB_XCNT(j)]); sum += c; cnt += (c > 0u) ? 1u : 0u; mine = (j == x) ? c : mine; }
        if (sum == G) break;
        __builtin_amdgcn_s_sleep(1);
        if ((++sp & 255u) == 0u) { if (xb_ld(&bar[XB_TMO])) break; if (sp > XB_SPIN_CAP) { atomicAdd(&bar[XB_TMO], 1u); break; } }
    }
    nloc = mine > 0u ? mine : 1u; nx = cnt > 0u ? cnt : 1u;
}
__device__ __forceinline__ void xcd_barrier(const XcdBarrier& b) {
    asm volatile("s_waitcnt vmcnt(0)" ::: "memory");
    __syncthreads();
    if (threadIdx.x == 0) {
        unsigned* bar = b.bar;
        __builtin_amdgcn_s_waitcnt(0);
        unsigned nloc = b.st[0], nx = b.st[1];
        if (nloc == 0u) { xcd_barrier_complete(bar, b.x, nloc, nx); b.st[0] = nloc; b.st[1] = nx; }
        const unsigned old = xb_add(&bar[XB_XSUB(b.x)], 1u);
        const unsigned gen = old / nloc;
        if (old + 1u == (gen + 1u) * nloc) {
            __builtin_amdgcn_fence(__ATOMIC_RELEASE, "agent");
            asm volatile("s_waitcnt vmcnt(0)" ::: "memory");
            const unsigned og = xb_add(&bar[XB_TOP], 1u);
            const unsigned tg = og / nx;
            if (og + 1u == (tg + 1u) * nx) xb_add(&bar[XB_TOPGEN], 1u);
            else XB_SPIN(xb_ld(&bar[XB_TOPGEN]) == tg, bar);
            __builtin_amdgcn_fence(__ATOMIC_ACQUIRE, "agent");
            xb_add(&bar[XB_XGEN(b.x)], 1u);
            asm volatile("s_waitcnt vmcnt(0)" ::: "memory");
        } else {
            XB_SPIN(xb_ld(&bar[XB_XGEN(b.x)]) == gen, bar);
            __builtin_amdgcn_fence(__ATOMIC_ACQUIRE, "agent");
            asm volatile("s_waitcnt vmcnt(0)" ::: "memory");
        }
    }
    __syncthreads();
}

struct Args { const float* in[22]; float* out; unsigned char* ws; int step_lo, step_hi; };

struct Frame {
    LAS unsigned char* lds;
    int tid, lane, wave, G;
    const float* const* in;
    float* out; unsigned char* ws;
};

__device__ __forceinline__ void frame_site(Frame& F, const Args& args) { int t = threadIdx.x; asm volatile("" : "+v"(t)); F.tid = t; F.lane = t & 63; F.wave = __builtin_amdgcn_readfirstlane(t >> 6);
    int z; asm volatile("s_mov_b32 %0, 0" : "=s"(z));
    F.in = args.in + z; F.ws = args.ws + z; F.out = args.out + z; }
__device__ __forceinline__ void frame_tid(Frame& F) { int t = threadIdx.x; asm volatile("" : "+v"(t)); F.tid = t; F.lane = t & 63; F.wave = __builtin_amdgcn_readfirstlane(t >> 6); }
enum { I_X = 0, I_C, I_CTX, I_CCTX, I_ADAW, I_ADAB, I_NORMG, I_F1W13, I_F1W2, I_F2W13, I_F2W2, I_WIN, I_WOUT, I_SGNG, I_SGW, I_SGB, I_CONVW, I_CONVB, I_GATEB, I_MNG, I_RPB, I_FNG };

__device__ __forceinline__ void p0_transpose_item(const float* W, int K, int N, bf16* WT, int k0, int n0, int dst_row0, LAS float* scr, int lane) {
#pragma unroll 8
    for (int i = 0; i < 32; ++i) { const int kk = 2 * i + (lane >> 5); scr[kk * 33 + (lane & 31)] = W[(size_t)(k0 + kk) * N + n0 + (lane & 31)]; }
    LDS_FENCE();
    const int c = lane & 7;
#pragma unroll
    for (int j = 0; j < 4; ++j) { const int n = (lane >> 3) + 8 * j; const LAS float* s = scr + (8 * c) * 33 + n;
        u32x4 o; o.x = pk2(s[0 * 33], s[1 * 33]); o.y = pk2(s[2 * 33], s[3 * 33]); o.z = pk2(s[4 * 33], s[5 * 33]); o.w = pk2(s[6 * 33], s[7 * 33]);
        *(u32x4*)(WT + (size_t)(dst_row0 + n) * K + k0 + 8 * c) = o; }
    LDS_FENCE();
}
__device__ __forceinline__ int w13_dst(int n) { return n < DFF ? (n >> 7) * 256 + (n & 127) : ((n - DFF) >> 7) * 256 + 128 + ((n - DFF) & 127); }
__device__ __forceinline__ int win_dst(int n) { return n < 5120 ? n : (n < 5152 ? 6656 + (n - 5120) : n - 32); }

__device__ __forceinline__ void p0_prologue(Frame& F) {
    const int gw = blockIdx.x * NWAVES + F.wave, NGW = F.G * NWAVES;
    const int gt = blockIdx.x * NTHR + F.tid, NGT = F.G * NTHR;
    { const f32x4* x4 = (const f32x4*)F.in[I_X]; const f32x4* c4 = (const f32x4*)F.in[I_CTX]; f32x4* h4 = (f32x4*)(F.ws + WS_H);
      const int nx = SEQ * D / 4, nc = CTXL * D / 4;
      for (int i = gt; i < nx + nc; i += NGT) h4[i] = i < nx ? x4[i] : c4[i - nx]; }
    { float* rt = (float*)(F.ws + WS_ROPE);
      for (int i = gt; i < 128 * 32; i += NGT) { const int pos = i >> 5, fi = i & 31; const float fr = exp2f(-(float)fi * (13.287712379549449f / 32.0f)); float s, c; sincosf((float)pos * fr, &s, &c); rt[2 * i] = c; rt[2 * i + 1] = s; }
      const float* sw = F.in[I_SGW]; bf16* so = (bf16*)(F.ws + WS_SGW);
      for (int i = gt; i < DEPTH * 4 * 128 * 128 / 2; i += NGT) ((unsigned*)so)[i] = pk2(sw[2 * i], sw[2 * i + 1]); }
    { LAS float* sc = (LAS float*)(F.lds);
      LAS float* red = (LAS float*)(F.lds + 16384);
      for (int i = F.tid; i < 2 * D; i += NTHR) { const float v = i < D ? F.in[I_C][i] : F.in[I_CCTX][i - D]; sc[i] = silu_f(v); }
      __syncthreads();
      for (int it = blockIdx.x; it < DEPTH * 72; it += F.G) {
          const int l = it / 72, cg = it % 72, n0 = cg * 256 + 4 * F.lane;
          const float* W = F.in[I_ADAW] + (size_t)l * D * NMODV + n0;
          f32x4 al = {0.f, 0.f, 0.f, 0.f}, ac = {0.f, 0.f, 0.f, 0.f};
          const int kb = F.wave * 256;
#pragma unroll 8
          for (int k = 0; k < 256; ++k) { const f32x4 w = *(const f32x4*)(W + (size_t)(kb + k) * NMODV); al += w * sc[kb + k]; ac += w * sc[D + kb + k]; }
#pragma unroll
          for (int j = 0; j < 4; ++j) { red[(F.wave * 256 + 4 * F.lane + j) * 2] = al[j]; red[(F.wave * 256 + 4 * F.lane + j) * 2 + 1] = ac[j]; }
          __syncthreads();
          { const int col = F.tid >> 1, t = F.tid & 1; float s = 0.f;
#pragma unroll
            for (int w = 0; w < 8; ++w) s += red[(w * 256 + col) * 2 + t];
            const int n = cg * 256 + col; s += F.in[I_ADAB][l * NMODV + n];
            const int ch = n >> 11; if (ch == 2 || ch == 8) s *= 0.5f;
            ((float*)(F.ws + WS_MOD))[(size_t)(l * 2 + t) * NMODV + n] = s; }
          __syncthreads();
      }
    }
    { LAS float* scr = (LAS float*)(F.lds + F.wave * 16384);
      constexpr int I_13 = 32 * 352, I_2 = 88 * 64, I_IN = 32 * 209, I_OUT = 32 * 64, I_LAYER = 2 * I_13 + 2 * I_2 + I_IN + I_OUT;
      for (int it = gw; it < DEPTH * I_LAYER; it += NGW) {
          const int l = it / I_LAYER; int r = it % I_LAYER;
          if (r < 2 * I_13) { const int f = r / I_13; r %= I_13; const int kb = r / 352, nb = r % 352;
              p0_transpose_item(F.in[f ? I_F2W13 : I_F1W13] + (size_t)l * D * 2 * DFF, D, 2 * DFF, (bf16*)(F.ws + WS_W13T + (size_t)(l * 2 + f) * SZ_W13T), kb * 64, nb * 32, w13_dst(nb * 32), scr, F.lane); continue; }
          r -= 2 * I_13;
          if (r < 2 * I_2) { const int f = r / I_2; r %= I_2; const int kb = r / 64, nb = r % 64;
              p0_transpose_item(F.in[f ? I_F2W2 : I_F1W2] + (size_t)l * DFF * D, DFF, D, (bf16*)(F.ws + WS_W2T + (size_t)(l * 2 + f) * SZ_W2T), kb * 64, nb * 32, nb * 32, scr, F.lane); continue; }
          r -= 2 * I_2;
          if (r < I_IN) { const int kb = r / 209, nb = r % 209;
              p0_transpose_item(F.in[I_WIN] + (size_t)l * D * DIN, D, DIN, (bf16*)(F.ws + WS_WINT + (size_t)l * SZ_WINT), kb * 64, nb * 32, win_dst(nb * 32), scr, F.lane); continue; }
          r -= I_IN;
          { const int kb = r / 64, nb = r % 64;
              p0_transpose_item(F.in[I_WOUT] + (size_t)l * D * D, D, D, (bf16*)(F.ws + WS_WOUTT + (size_t)l * SZ_WOUTT), kb * 64, nb * 32, nb * 32, scr, F.lane); }
      }
    }
}

__device__ __forceinline__ void norm_phase(Frame& F, const float* g, const float* modl  , int ishift, int iscale, int M, int nparts) {
    const int gw = blockIdx.x * NWAVES + F.wave, NGW = F.G * NWAVES;
    float* H = (float*)(F.ws + WS_H); bf16* A = (bf16*)(F.ws + WS_ABUF);
    for (int row = gw; row < M; row += NGW) {
        const int t = row >= SEQ ? 1 : 0;
        const float* sh = modl + (size_t)t * NMODV + ishift * D; const float* scl = modl + (size_t)t * NMODV + iscale * D;
        const f32x4* xr = (const f32x4*)(H + (size_t)row * D) + F.lane;
        f32x4 v[8]; float s = 0.f;
#pragma unroll
        for (int j = 0; j < 8; ++j) v[j] = xr[64 * j];
        if (t && nparts > 0) {
            const f32x4* sl = (const f32x4*)(F.ws + WS_SLAB) + (size_t)(row - SEQ) * (D / 4) + F.lane;
            for (int p = 0; p < nparts; ++p) {
#pragma unroll
                for (int j = 0; j < 8; ++j) v[j] += sl[(size_t)p * 256 * (D / 4) + 64 * j]; }
            f32x4* xw = (f32x4*)(H + (size_t)row * D) + F.lane;
#pragma unroll
            for (int j = 0; j < 8; ++j) xw[64 * j] = v[j];
        }
#pragma unroll
        for (int j = 0; j < 8; ++j) s += (v[j][0] * v[j][0] + v[j][1] * v[j][1]) + (v[j][2] * v[j][2] + v[j][3] * v[j][3]);
        const float rstd = rsqrtf(wsum(s) * (1.0f / D) + EPS);
        u32x2* o = (u32x2*)(A + (size_t)row * D) + F.lane;
#pragma unroll
        for (int j = 0; j < 8; ++j) { const int c = 4 * F.lane + 256 * j;
            const f32x4 gg = *(const f32x4*)(g + c), ss = *(const f32x4*)(scl + c), hh = *(const f32x4*)(sh + c);
            const f32x4 y = (v[j] * rstd) * gg * (ss + 1.0f) + hh;
            u32x2 w; w.x = pk2(y[0], y[1]); w.y = pk2(y[2], y[3]); o[64 * j] = w; }
    }
}
__device__ __forceinline__ void final_norm_phase(Frame& F) {
    const int gw = blockIdx.x * NWAVES + F.wave, NGW = F.G * NWAVES;
    const float* H = (const float*)(F.ws + WS_H); const float* g = F.in[I_FNG];
    for (int row = gw; row < SEQ; row += NGW) {
        const f32x4* xr = (const f32x4*)(H + (size_t)row * D) + F.lane;
        f32x4 v[8]; float s = 0.f;
#pragma unroll
        for (int j = 0; j < 8; ++j) { v[j] = xr[64 * j]; s += (v[j][0] * v[j][0] + v[j][1] * v[j][1]) + (v[j][2] * v[j][2] + v[j][3] * v[j][3]); }
        const float rstd = rsqrtf(wsum(s) * (1.0f / D) + EPS);
        f32x4* o = (f32x4*)(F.out + (size_t)row * D) + F.lane;
#pragma unroll
        for (int j = 0; j < 8; ++j) o[64 * j] = (v[j] * rstd) * *(const f32x4*)(g + 4 * F.lane + 256 * j);
    }
}

__device__ __forceinline__ void tile_rows_out(const LAS short* tile, bf16* dst, int row0, int tokb, int lane) {
    LDS_FENCE();
#pragma unroll
    for (int it = 0; it < 8; ++it) { const int idx = it * 64 + lane, r = idx >> 3, seg = idx & 7;
        const bf16x8 v = *(const LAS bf16x8*)(tile + r * 72 + 8 * seg);
        *(bf16x8*)(dst + (size_t)(row0 + r) * MTOK + tokb + 8 * seg) = v; }
    LDS_FENCE();
}
__device__ __forceinline__ void prep_transpose_item(const bf16* P, int c0, bf16* dst, int drow0, int tb, LAS short* tile, int lane) {
#pragma unroll
    for (int it = 0; it < 8; ++it) { const int idx = it * 64 + lane, tok = idx >> 3, seg = idx & 7;
        const bf16x8 v = *(const bf16x8*)(P + (size_t)(tb * 64 + tok) * DINP + c0 + 8 * seg);
#pragma unroll
        for (int j = 0; j < 8; ++j) tile[(8 * seg + j) * 72 + tok] = v[j]; }
    tile_rows_out(tile, dst, drow0, tb * 64, lane);
}
__device__ __forceinline__ void prep_conv_item(Frame& F, const bf16* P, const float* cw  , const float* cb, int tb, int cg, LAS short* tile, int lane) {
    const int i = lane & 31, ts = lane >> 5, ch0 = cg * 64 + i, ch1 = ch0 + 32;
    const bool isK = cg >= 16; const int half = cg & 1;
    const int tok0 = tb * 64, t0 = tok0 + 32 * ts;
    const int seq_lo = tok0 < SEQ ? 0 : SEQ, seq_hi = tok0 < SEQ ? SEQ : MTOK;
    float w0[5], w1[5];
#pragma unroll
    for (int j = 0; j < 5; ++j) { w0[j] = cw[j * 2048 + ch0]; w1[j] = cw[j * 2048 + ch1]; }
    const float b0 = cb[ch0], b1 = cb[ch1];
    const bf16* src = P + PC_MQ;
    float x0[5], x1[5];
#pragma unroll
    for (int j = 0; j < 4; ++j) { const int t = t0 + j - 2; const bool ok = t >= seq_lo && t < seq_hi;
        x0[j] = ok ? bf2f((short)src[(size_t)t * DINP + ch0]) : 0.f; x1[j] = ok ? bf2f((short)src[(size_t)t * DINP + ch1]) : 0.f; }
    const float* rope = (const float*)(F.ws + WS_ROPE);
    const bool lat = tok0 < SEQ;
    bf16* dstn = (bf16*)(F.ws + (isK ? WS_KC : WS_QC));
    const int chn0 = ch0 & 1023;
    const float qs = isK ? 1.0f : 0.08838834764831845f;
    for (int tt = 0; tt < 32; ++tt) {
        const int t = t0 + tt;
        { const int tn = t + 2; const bool ok = tn >= seq_lo && tn < seq_hi;
          x0[4] = ok ? bf2f((short)src[(size_t)tn * DINP + ch0]) : 0.f; x1[4] = ok ? bf2f((short)src[(size_t)tn * DINP + ch1]) : 0.f; }
        float y0 = b0, y1 = b1;
#pragma unroll
        for (int j = 0; j < 5; ++j) { y0 += w0[j] * x0[j]; y1 += w1[j] * x1[j]; }
        y0 = silu_f(y0); y1 = silu_f(y1);
        if (lat) { const int pos = half ? (t & 63) : (t >> 6); const float c = rope[(pos * 32 + i) * 2], s = rope[(pos * 32 + i) * 2 + 1];
            const float r0 = y0 * c - y1 * s, r1 = y0 * s + y1 * c; y0 = r0; y1 = r1; }
        y0 *= qs; y1 *= qs;
        const short o0 = f2bf(y0), o1 = f2bf(y1);
        dstn[(size_t)t * 1024 + chn0] = (bf16)o0; dstn[(size_t)t * 1024 + chn0 + 32] = (bf16)o1;
        if (isK) { tile[i * 72 + 32 * ts + tt] = o0; tile[(i + 32) * 72 + 32 * ts + tt] = o1; }
#pragma unroll
        for (int j = 0; j < 4; ++j) { x0[j] = x0[j + 1]; x1[j] = x1[j + 1]; }
    }
    if (isK) tile_rows_out(tile, (bf16*)(F.ws + WS_KCT), (cg - 16) * 64, tok0, lane);
}
__device__ __forceinline__ void prep_sgu_item(Frame& F, const bf16* P, const float* ng, int tb, int cg, LAS short* tile, int lane) {
    const int tok0 = tb * 64; float myr = 0.f;
    for (int tok = 0; tok < 64; ++tok) {
        const bf16x8 v = *(const bf16x8*)(P + (size_t)(tok0 + tok) * DINP + PC_V + 8 * lane); float s = 0.f;
#pragma unroll
        for (int j = 0; j < 8; ++j) { const float gl = gelu_tanh(bf2f(v[j])); s += gl * gl; }
        s = wsum(s); const float r = rsqrtf(s * (1.0f / 512.0f) + EPS); if (lane == tok) myr = r;
    }
    const bf16* rowp = P + (size_t)(tok0 + lane) * DINP + PC_V + cg * 64;
#pragma unroll
    for (int seg = 0; seg < 8; ++seg) { const bf16x8 v = *(const bf16x8*)(rowp + 8 * seg);
#pragma unroll
        for (int j = 0; j < 8; ++j) tile[(8 * seg + j) * 72 + lane] = f2bf(gelu_tanh(bf2f(v[j])) * myr * ng[cg * 64 + 8 * seg + j]); }
    tile_rows_out(tile, (bf16*)(F.ws + WS_VNT), cg * 64, tok0, lane);
}
__device__ __forceinline__ void prep_phase(Frame& F, int l) {
    const int gw = blockIdx.x * NWAVES + F.wave, NGW = F.G * NWAVES;
    const bf16* P = (const bf16*)(F.ws + WS_P);
    LAS short* tile = (LAS short*)(F.lds + F.wave * 16384);
    constexpr int NTB = MTOK / 64;
    constexpr int N_CONV = NTB * 32, N_SGU = NTB * 8, N_MVT = NTB * 16, N_NAVT = NTB * 8;
    for (int it = gw; it < N_CONV + N_SGU + N_MVT + N_NAVT; it += NGW) {
        int r = it;
        if (r < N_CONV) { prep_conv_item(F, P, F.in[I_CONVW] + (size_t)l * 5 * 2048, F.in[I_CONVB] + (size_t)l * 2048, r >> 5, r & 31, tile, F.lane); continue; } r -= N_CONV;
        if (r < N_SGU) { prep_sgu_item(F, P, F.in[I_SGNG] + (size_t)l * 512, r >> 3, r & 7, tile, F.lane); continue; } r -= N_SGU;
        if (r < N_MVT) { prep_transpose_item(P, PC_MV + (r & 15) * 64, (bf16*)(F.ws + WS_MVT), (r & 15) * 64, r >> 4, tile, F.lane); continue; } r -= N_MVT;
        prep_transpose_item(P, PC_NV + (r & 7) * 64, (bf16*)(F.ws + WS_NAVT), (r & 7) * 64, r >> 3, tile, F.lane);
    }
}

struct MG { float i_f[2], b_f[2], i_b[2], b_b[2]; float bl_f, bl_b; };
__device__ __forceinline__ void mlstm_gates(const float* G, int lane, MG& g) {
    float lf[2], lb[2];
#pragma unroll
    for (int x = 0; x < 2; ++x) { const float* p = G + (size_t)(lane + 64 * x) * 32; g.i_f[x] = p[0]; lf[x] = logsig(p[8]); g.i_b[x] = p[16]; lb[x] = logsig(p[24]); }
    const float s0 = scan_up_add(lf[0], lane), t0 = __shfl(s0, 63), s1 = scan_up_add(lf[1], lane) + t0;
    g.b_f[0] = s0; g.b_f[1] = s1; g.bl_f = __shfl(s1, 63);
    const float r1 = scan_down_add(lb[1], lane), t1 = __shfl(r1, 0), r0 = scan_down_add(lb[0], lane) + t1;
    g.b_b[0] = r0; g.b_b[1] = r1; g.bl_b = __shfl(r0, 0);
}
__device__ __forceinline__ void mlstm_local_unit(Frame& F, int c, int h, LAS float* wsl) {
    const int lane = F.lane, w = F.wave, fr = lane & 15, fq = lane >> 4, tok0 = c * 128;
    const int posf = (c + 2) % NCHUNK, posb = 65 - c;
    MG g; mlstm_gates((const float*)(F.ws + WS_GATES) + (size_t)tok0 * 32 + h, lane, g);
    float gf[2], gb[2];
#pragma unroll
    for (int x = 0; x < 2; ++x) { gf[x] = g.bl_f - g.b_f[x] + g.i_f[x]; gb[x] = g.bl_b - g.b_b[x] + g.i_b[x]; }
    const float gmf = wmax(fmaxf(gf[0], gf[1])), gmb = wmax(fmaxf(gb[0], gb[1]));
    wsl[lane] = __expf(gf[0] - gmf); wsl[64 + lane] = __expf(gf[1] - gmf); wsl[128 + lane] = __expf(gb[0] - gmb); wsl[192 + lane] = __expf(gb[1] - gmb);
    LDS_FENCE();
    const bf16* krow = (const bf16*)(F.ws + WS_KCT) + (size_t)(h * 128 + 16 * w + fr) * MTOK + tok0 + 8 * fq;
    bf16x8 yf[4], yb[4]; float unf = 0.f, unb = 0.f;
#pragma unroll
    for (int ks = 0; ks < 4; ++ks) { const bf16x8 raw = *(const bf16x8*)(krow + 32 * ks);
        const f32x4 wf0 = *(const LAS f32x4*)(wsl + 32 * ks + 8 * fq), wf1 = *(const LAS f32x4*)(wsl + 32 * ks + 8 * fq + 4);
        const f32x4 wb0 = *(const LAS f32x4*)(wsl + 128 + 32 * ks + 8 * fq), wb1 = *(const LAS f32x4*)(wsl + 128 + 32 * ks + 8 * fq + 4);
        float a[8], b[8];
#pragma unroll
        for (int j = 0; j < 8; ++j) { const float kv = bf2f(raw[j]); a[j] = kv * (j < 4 ? wf0[j & 3] : wf1[j & 3]); b[j] = kv * (j < 4 ? wb0[j & 3] : wb1[j & 3]); unf += a[j]; unb += b[j]; }
        u32x4 pa, pb; pa.x = pk2(a[0], a[1]); pa.y = pk2(a[2], a[3]); pa.z = pk2(a[4], a[5]); pa.w = pk2(a[6], a[7]);
        pb.x = pk2(b[0], b[1]); pb.y = pk2(b[2], b[3]); pb.z = pk2(b[4], b[5]); pb.w = pk2(b[6], b[7]);
        yf[ks] = __builtin_bit_cast(bf16x8, pa); yb[ks] = __builtin_bit_cast(bf16x8, pb); }
    float* uf = (float*)(F.ws + WS_UT) + ((size_t)((0 * NCHUNK + posf) * 8 + h) * 128) * 128;
    float* ub = (float*)(F.ws + WS_UT) + ((size_t)((1 * NCHUNK + posb) * 8 + h) * 128) * 128;
#pragma unroll
    for (int et = 0; et < 8; ++et) {
        const bf16* vrow = (const bf16*)(F.ws + WS_MVT) + (size_t)(h * 128 + 16 * et + fr) * MTOK + tok0 + 8 * fq;
        f32x4 af = {0.f, 0.f, 0.f, 0.f}, ab = {0.f, 0.f, 0.f, 0.f};
#pragma unroll
        for (int ks = 0; ks < 4; ++ks) { const bf16x8 xf = *(const bf16x8*)(vrow + 32 * ks); af = mfma16(xf, yf[ks], af); ab = mfma16(xf, yb[ks], ab); }
#pragma unroll
        for (int r = 0; r < 4; ++r) { uf[(size_t)(16 * et + 4 * fq + r) * 128 + 16 * w + fr] = af[r]; ub[(size_t)(16 * et + 4 * fq + r) * 128 + 16 * w + fr] = ab[r]; }
    }
    unf = qsum(unf); unb = qsum(unb);
    if (fq == 0) { ((float*)(F.ws + WS_UN))[((size_t)(0 * NCHUNK + posf) * 8 + h) * 128 + 16 * w + fr] = unf; ((float*)(F.ws + WS_UN))[((size_t)(1 * NCHUNK + posb) * 8 + h) * 128 + 16 * w + fr] = unb; }
    if (w == 0 && lane == 0) { float* bg = (float*)(F.ws + WS_BLGM);
        bg[((0 * NCHUNK + posf) * 8 + h) * 2] = g.bl_f; bg[((0 * NCHUNK + posf) * 8 + h) * 2 + 1] = gmf; bg[((1 * NCHUNK + posb) * 8 + h) * 2] = g.bl_b; bg[((1 * NCHUNK + posb) * 8 + h) * 2 + 1] = gmb; }
    LDS_FENCE();
}
__device__ __forceinline__ void scan_phase(Frame& F) {
    const float* UT = (const float*)(F.ws + WS_UT); const float* UN = (const float*)(F.ws + WS_UN); const float* BG = (const float*)(F.ws + WS_BLGM);
    bf16* CT = (bf16*)(F.ws + WS_CT); float* CN = (float*)(F.ws + WS_CN); float* CM = (float*)(F.ws + WS_CM);
    const int NT = F.G * NTHR;
    for (int gid = blockIdx.x * NTHR + F.tid; gid < 65536 + 512; gid += NT) {
        if (gid < 65536) {
            const int d4 = gid & 31, e = (gid >> 5) & 127, h = (gid >> 12) & 7, dir = gid >> 15;
            const size_t base = ((size_t)(dir * NCHUNK * 8 + h) * 128 + e) * 128 + d4 * 4, pstride = (size_t)8 * 128 * 128;
            f32x4 C = {0.f, 0.f, 0.f, 0.f}; float m = 0.f;
#pragma unroll 6
            for (int pos = 0; pos < NCHUNK; ++pos) {
                u32x2 o; o.x = pk2(C[0], C[1]); o.y = pk2(C[2], C[3]); *(u32x2*)(CT + base + pos * pstride) = o;
                if (e == 0 && d4 == 0) CM[(dir * NCHUNK + pos) * 8 + h] = m;
                const float bl = BG[((dir * NCHUNK + pos) * 8 + h) * 2], gm = BG[((dir * NCHUNK + pos) * 8 + h) * 2 + 1];
                const float mn = fmaxf(bl + m, gm), dec = __expf(bl + m - mn), sc = __expf(gm - mn);
                const f32x4 u = *(const f32x4*)(UT + base + pos * pstride);
                C = C * dec + u * sc; m = mn;
            }
        } else {
            const int k = gid - 65536, d4 = k & 31, h = (k >> 5) & 7, dir = k >> 8;
            const size_t base = ((size_t)(dir * NCHUNK * 8 + h)) * 128 + d4 * 4, pstride = (size_t)8 * 128;
            f32x4 C = {0.f, 0.f, 0.f, 0.f}; float m = 0.f;
            for (int pos = 0; pos < NCHUNK; ++pos) {
                *(f32x4*)(CN + base + pos * pstride) = C;
                const float bl = BG[((dir * NCHUNK + pos) * 8 + h) * 2], gm = BG[((dir * NCHUNK + pos) * 8 + h) * 2 + 1];
                const float mn = fmaxf(bl + m, gm), dec = __expf(bl + m - mn), sc = __expf(gm - mn);
                const f32x4 u = *(const f32x4*)(UN + base + pos * pstride);
                C = C * dec + u * sc; m = mn;
            }
        }
    }
}
__device__ __forceinline__ void mlstm_out_unit(Frame& F, int l, int c, int h, LAS float* wsl) {
    const int lane = F.lane, w = F.wave, fr = lane & 15, fq = lane >> 4, tok0 = c * 128, t = 16 * w + fr;
    const int posf = (c + 2) % NCHUNK, posb = 65 - c;
    MG g; mlstm_gates((const float*)(F.ws + WS_GATES) + (size_t)tok0 * 32 + h, lane, g);
    const float mf = ((const float*)(F.ws + WS_CM))[(0 * NCHUNK + posf) * 8 + h], mb = ((const float*)(F.ws + WS_CM))[(1 * NCHUNK + posb) * 8 + h];
    float cf[2], cb[2];
#pragma unroll
    for (int x = 0; x < 2; ++x) { cf[x] = g.i_f[x] - g.b_f[x]; cb[x] = g.i_b[x] - g.b_b[x]; }
    float pm[2], sm[2];
    { const float p0 = scan_up_max(cf[0], lane), tt = __shfl(p0, 63), p1 = fmaxf(scan_up_max(cf[1], lane), tt); pm[0] = p0; pm[1] = p1;
      const float q1 = scan_down_max(cb[1], lane), uu = __shfl(q1, 0), q0 = fmaxf(scan_down_max(cb[0], lane), uu); sm[0] = q0; sm[1] = q1; }
#pragma unroll
    for (int x = 0; x < 2; ++x) { const int s = lane + 64 * x;
        const float Mf = fmaxf(pm[x], mf), Mb = fmaxf(sm[x], mb);
        wsl[s] = cf[x]; wsl[128 + s] = cb[x];
        wsl[256 + s] = -Mf; wsl[384 + s] = __expf(mf - Mf); wsl[512 + s] = __expf(-(g.b_f[x] + Mf));
        wsl[640 + s] = -Mb; wsl[768 + s] = __expf(mb - Mb); wsl[896 + s] = __expf(-(g.b_b[x] + Mb)); }
    LDS_FENCE();
    const float rowf = wsl[256 + t], a_f = wsl[384 + t], fl_f = wsl[512 + t], rowb = wsl[640 + t], a_b = wsl[768 + t], fl_b = wsl[896 + t];
    const bf16* qrow = (const bf16*)(F.ws + WS_QC) + (size_t)(tok0 + t) * 1024 + h * 128 + 8 * fq;
    bf16x8 qf[4];
#pragma unroll
    for (int ks = 0; ks < 4; ++ks) qf[ks] = *(const bf16x8*)(qrow + 32 * ks);
    bf16x8 pf[4], pb[4]; float dsf = 0.f, dsb = 0.f;
#pragma unroll
    for (int kb = 0; kb < 4; ++kb) {
        float vf[8], vb[8];
#pragma unroll
        for (int hh = 0; hh < 2; ++hh) { const int st = 2 * kb + hh;
            const bf16* krow = (const bf16*)(F.ws + WS_KC) + (size_t)(tok0 + 16 * st + fr) * 1024 + h * 128 + 8 * fq;
            f32x4 S = {0.f, 0.f, 0.f, 0.f};
#pragma unroll
            for (int ks = 0; ks < 4; ++ks) S = mfma16(*(const bf16x8*)(krow + 32 * ks), qf[ks], S);
            const f32x4 c4f = *(const LAS f32x4*)(wsl + 16 * st + 4 * fq), c4b = *(const LAS f32x4*)(wsl + 128 + 16 * st + 4 * fq);
#pragma unroll
            for (int r = 0; r < 4; ++r) { const int s = 16 * st + 4 * fq + r;
                const float ef = (s <= t) ? __expf(rowf + c4f[r]) : 0.f, eb = (s >= t) ? __expf(rowb + c4b[r]) : 0.f;
                const float p1 = S[r] * ef, p2 = S[r] * eb; vf[4 * hh + r] = p1; vb[4 * hh + r] = p2; dsf += p1; dsb += p2; } }
        u32x4 a, b; a.x = pk2(vf[0], vf[1]); a.y = pk2(vf[2], vf[3]); a.z = pk2(vf[4], vf[5]); a.w = pk2(vf[6], vf[7]);
        b.x = pk2(vb[0], vb[1]); b.y = pk2(vb[2], vb[3]); b.z = pk2(vb[4], vb[5]); b.w = pk2(vb[6], vb[7]);
        pf[kb] = __builtin_bit_cast(bf16x8, a); pb[kb] = __builtin_bit_cast(bf16x8, b);
        __builtin_amdgcn_sched_barrier(0);
    }
    dsf = qsum(dsf); dsb = qsum(dsb);
    const float* nf = (const float*)(F.ws + WS_CN) + ((size_t)(0 * NCHUNK + posf) * 8 + h) * 128; const float* nb = (const float*)(F.ws + WS_CN) + ((size_t)(1 * NCHUNK + posb) * 8 + h) * 128;
    float qnf = 0.f, qnb = 0.f;
#pragma unroll
    for (int ks = 0; ks < 4; ++ks) { const f32x4 n0 = *(const f32x4*)(nf + 32 * ks + 8 * fq), n1 = *(const f32x4*)(nf + 32 * ks + 8 * fq + 4), m0 = *(const f32x4*)(nb + 32 * ks + 8 * fq), m1 = *(const f32x4*)(nb + 32 * ks + 8 * fq + 4);
#pragma unroll
        for (int j = 0; j < 8; ++j) { const float qv = bf2f(qf[ks][j]); qnf += qv * (j < 4 ? n0[j & 3] : n1[j & 3]); qnb += qv * (j < 4 ? m0[j & 3] : m1[j & 3]); } }
    qnf = qsum(qnf); qnb = qsum(qnb);
    const float inv_f = 1.0f / fmaxf(fabsf(a_f * qnf + dsf), fl_f), inv_b = 1.0f / fmaxf(fabsf(a_b * qnb + dsb), fl_b);
    const bf16* ctf = (const bf16*)(F.ws + WS_CT) + ((size_t)((0 * NCHUNK + posf) * 8 + h) * 128) * 128;
    const bf16* ctb = (const bf16*)(F.ws + WS_CT) + ((size_t)((1 * NCHUNK + posb) * 8 + h) * 128) * 128;
    f32x4 hs[8]; float ss = 0.f;
#pragma unroll
    for (int et = 0; et < 8; ++et) {
        f32x4 af = {0.f, 0.f, 0.f, 0.f}, ab = {0.f, 0.f, 0.f, 0.f};
#pragma unroll
        for (int ks = 0; ks < 4; ++ks) { af = mfma16(*(const bf16x8*)(ctf + (size_t)(16 * et + fr) * 128 + 32 * ks + 8 * fq), qf[ks], af);
                                         ab = mfma16(*(const bf16x8*)(ctb + (size_t)(16 * et + fr) * 128 + 32 * ks + 8 * fq), qf[ks], ab); }
        af = af * a_f; ab = ab * a_b;
        const bf16* vrow = (const bf16*)(F.ws + WS_MVT) + (size_t)(h * 128 + 16 * et + fr) * MTOK + tok0 + 4 * fq;
#pragma unroll
        for (int kb = 0; kb < 4; ++kb) { const bf16x8 xf = cat8(*(const bf16x4*)(vrow + 32 * kb), *(const bf16x4*)(vrow + 32 * kb + 16));
            af = mfma16(xf, pf[kb], af); ab = mfma16(xf, pb[kb], ab); }
        hs[et] = af * inv_f + ab * inv_b;
        ss += (hs[et][0] * hs[et][0] + hs[et][1] * hs[et][1]) + (hs[et][2] * hs[et][2] + hs[et][3] * hs[et][3]);
        __builtin_amdgcn_sched_barrier(0);
    }
    ss = qsum(ss);
    const float rstd = rsqrtf(ss * (1.0f / 128.0f) + EPS);
    const float* ng = F.in[I_MNG] + (size_t)l * 1024 + h * 128;
    const bf16* orow = (const bf16*)(F.ws + WS_P) + (size_t)(tok0 + t) * DINP + PC_MO + h * 128;
    bf16* crow = (bf16*)(F.ws + WS_CAT) + (size_t)(tok0 + t) * D + 512 + h * 128;
#pragma unroll
    for (int et = 0; et < 8; ++et) { const int e = 16 * et + 4 * fq; const bf16x4 ov = *(const bf16x4*)(orow + e); const f32x4 gg = *(const f32x4*)(ng + e);
        float y[4];
#pragma unroll
        for (int r = 0; r < 4; ++r) y[r] = sigmoid_f(bf2f(ov[r])) * (hs[et][r] * rstd * gg[r]);
        *(bf16x4*)(crow + e) = pk4(y[0], y[1], y[2], y[3]); }
    LDS_FENCE();
}

__device__ __forceinline__ void sgu_unit(Frame& F, int l, int c, int g) {
    const int lane = F.lane, w = F.wave, fr = lane & 15, fq = lane >> 4, tok0 = c * 128, t = 16 * w + fr;
    const bf16* wrow = (const bf16*)(F.ws + WS_SGW) + ((size_t)(l * 4 + g) * 128 + t) * 128 + 8 * fq;
    bf16x8 yf[4];
#pragma unroll
    for (int ks = 0; ks < 4; ++ks) yf[ks] = *(const bf16x8*)(wrow + 32 * ks);
    const float bs = F.in[I_SGB][(size_t)(l * 4 + g) * 128 + t];
    const bf16* urow = (const bf16*)(F.ws + WS_P) + (size_t)(tok0 + t) * DINP + PC_U + g * 128;
    bf16* crow = (bf16*)(F.ws + WS_CAT) + (size_t)(tok0 + t) * D + g * 128;
#pragma unroll
    for (int ct = 0; ct < 8; ++ct) {
        const bf16* vrow = (const bf16*)(F.ws + WS_VNT) + (size_t)(g * 128 + 16 * ct + fr) * MTOK + tok0 + 8 * fq;
        f32x4 a = {0.f, 0.f, 0.f, 0.f};
#pragma unroll
        for (int ks = 0; ks < 4; ++ks) a = mfma16(*(const bf16x8*)(vrow + 32 * ks), yf[ks], a);
        const int cc = 16 * ct + 4 * fq; const bf16x4 uv = *(const bf16x4*)(urow + cc);
        float y[4];
#pragma unroll
        for (int r = 0; r < 4; ++r) y[r] = gelu_tanh(bf2f(uv[r])) * (a[r] + bs);
        *(bf16x4*)(crow + cc) = pk4(y[0], y[1], y[2], y[3]);
    }
}

template <bool LOC> __device__ __forceinline__ void na_part(Frame& F, const float* rpb, bf16x8 qf0, bf16x8 qf1, int h, int r, int b, int lane, float& mx_o, float& sum_o, f32x4 (&O)[4]) {
    const int fr = lane & 15, fq = lane >> 4;
    const bf16* P = (const bf16*)(F.ws + WS_P); const bf16* VT = (const bf16*)(F.ws + WS_NAVT);
    int rs = r - 4; rs = rs < 0 ? 0 : (rs > 120 ? 120 : rs);
    int kc0 = 16 * b - 8; kc0 = kc0 < 0 ? 0 : (kc0 > 32 ? 32 : kc0);
    const int qc = 16 * b + fr; int cs = qc - 8; cs = cs < 0 ? 0 : (cs > 48 ? 48 : cs);
    const int base0 = LOC ? rs * 64 + kc0 : SEQ;
    const bf16* kbase = P + (size_t)(base0 + fr) * DINP + PC_NK + h * 64 + 8 * fq;
    const float* rpbh = rpb + (h * 15 + (rs - r + 7)) * 31 + (kc0 + 4 * fq - qc + 15);
    const int kcl = kc0 + 4 * fq;
#define NA_TILE(kt, a) do { const bf16* krow_ = kbase + (size_t)(LOC ? 64 * ((kt) >> 1) + 16 * ((kt) & 1) : 16 * (kt)) * DINP; \
        a = (f32x4){0.f, 0.f, 0.f, 0.f}; a = mfma16(*(const bf16x8*)krow_, qf0, a); a = mfma16(*(const bf16x8*)(krow_ + 32), qf1, a); \
        _Pragma("unroll") for (int rr = 0; rr < 4; ++rr) { float v_ = a[rr] * 0.125f; \
            if (LOC) { const int kc_ = kcl + 16 * ((kt) & 1) + rr; const bool valid_ = kc_ >= cs && kc_ < cs + 16; \
                int o_ = 31 * ((kt) >> 1) + 16 * ((kt) & 1) + rr; const float bias_ = valid_ ? rpbh[o_] : 0.f; v_ = valid_ ? v_ + bias_ : -1e30f; } \
            a[rr] = v_; } } while (0)
    float mx = -1e30f;
#pragma unroll 2
    for (int kt = 0; kt < 16; ++kt) { f32x4 a; NA_TILE(kt, a); mx = fmaxf(fmaxf(mx, fmaxf(a[0], a[1])), fmaxf(a[2], a[3])); }
    mx = qmax(mx);
    float sum = 0.f;
#pragma unroll
    for (int dt = 0; dt < 4; ++dt) O[dt] = (f32x4){0.f, 0.f, 0.f, 0.f};
    const bf16* vbase = VT + (size_t)(h * 64 + fr) * MTOK + base0 + 4 * fq;
    for (int kb = 0; kb < 8; ++kb) {
        f32x4 a0, a1; NA_TILE(2 * kb, a0); NA_TILE(2 * kb + 1, a1);
#pragma unroll
        for (int rr = 0; rr < 4; ++rr) { a0[rr] = __expf(a0[rr] - mx); a1[rr] = __expf(a1[rr] - mx); sum += a0[rr] + a1[rr]; }
        u32x4 pp; pp.x = pk2(a0[0], a0[1]); pp.y = pk2(a0[2], a0[3]); pp.z = pk2(a1[0], a1[1]); pp.w = pk2(a1[2], a1[3]);
        const bf16x8 pfrag = __builtin_bit_cast(bf16x8, pp);
#pragma unroll
        for (int dt = 0; dt < 4; ++dt) { const bf16* vrow = vbase + (size_t)(16 * dt) * MTOK + (LOC ? 64 * kb : 32 * kb);
            O[dt] = mfma16(cat8(*(const bf16x4*)vrow, *(const bf16x4*)(vrow + 16)), pfrag, O[dt]); }
    }
#undef NA_TILE
    mx_o = mx; sum_o = qsum(sum);
}
template <bool LOCAL> __device__ __forceinline__ void na_wave(Frame& F, const float* rpb  , int tokq0, int h, int r, int b, int lane) {
    const int fr = lane & 15, fq = lane >> 4, tokq = tokq0 + fr;
    const bf16* qrow = (const bf16*)(F.ws + WS_P) + (size_t)tokq * DINP + PC_NQ + h * 64 + 8 * fq;
    const bf16x8 qf0 = *(const bf16x8*)qrow, qf1 = *(const bf16x8*)(qrow + 32);
    float m2, l2; f32x4 O2[4];
    na_part<false>(F, rpb, qf0, qf1, h, r, b, lane, m2, l2, O2);
    if (LOCAL) {
        float m1, l1; f32x4 O1[4];
        na_part<true>(F, rpb, qf0, qf1, h, r, b, lane, m1, l1, O1);
        const float M = fmaxf(m1, m2), e1 = __expf(m1 - M), e2 = __expf(m2 - M);
        l2 = l1 * e1 + l2 * e2;
#pragma unroll
        for (int dt = 0; dt < 4; ++dt) O2[dt] = O1[dt] * e1 + O2[dt] * e2;
    }
    const float inv = 1.0f / l2;
    bf16* crow = (bf16*)(F.ws + WS_CAT) + (size_t)tokq * D + 1536 + h * 64;
#pragma unroll
    for (int dt = 0; dt < 4; ++dt) *(bf16x4*)(crow + 16 * dt + 4 * fq) = pk4(O2[dt][0] * inv, O2[dt][1] * inv, O2[dt][2] * inv, O2[dt][3] * inv);
}

__global__ void __launch_bounds__(NTHR, 2) mk_fwd(Args args) {
    extern __shared__ __attribute__((aligned(16))) unsigned char lds[];
    Frame F;
    F.lds = (LAS unsigned char*)lds;
    frame_tid(F);
    F.G = gridDim.x; F.in = args.in; F.out = args.out; F.ws = args.ws;
    volatile LAS unsigned* MISC = (volatile LAS unsigned*)(F.lds + LDSCTL_OFF);
    for (int u = F.tid; u < (LDS_BYTES - LDSCTL_OFF) / 4; u += NTHR) MISC[u] = 0u;
    __syncthreads();
#if !MK_SPLIT
    (void)xcd_barrier_post((unsigned*)(args.ws + WS_CTL) + 4096, MISC + 8);
#endif
    const int lo = args.step_lo, hi = args.step_hi;
#define MODL ((const float*)(F.ws + WS_MOD) + (size_t)l * 2 * NMODV)
    int step = 0;
#define IN_STEP() (step >= lo && step < hi && (frame_site(F, args), true))
#if MK_SPLIT
#define END_STEP() do { ++step; } while (0)
#else
#define END_STEP() do { if (step >= lo && step + 1 < hi) { XcdBarrier b_; b_.bar = (unsigned*)(args.ws + WS_CTL) + 4096; b_.x = xb_xcc_id(); b_.st = MISC + 8; xcd_barrier(b_); } ++step; } while (0)
#endif

    if (IN_STEP()) for (int rp = 0; rp < REP_PRO; ++rp) p0_prologue(F);
    END_STEP();

    for (int l = 0; l < DEPTH; ++l) {
        for (int f = 0; f < 2; ++f) {
            if (IN_STEP()) for (int rp = 0; rp < REP_NORM; ++rp) norm_phase(F, F.in[I_NORMG] + (size_t)(l * 3 + 2 * f) * D, MODL, 6 * f, 6 * f + 1, MTOK, f == 0 ? (l == 0 ? 0 : 11) : 4);
            END_STEP();
            if (IN_STEP()) for (int rp = 0; rp < REP_G1; ++rp) {
                pg8::Gemm g{(const bf16*)(F.ws + WS_ABUF), (const bf16*)(F.ws + WS_W13T + (size_t)(l * 2 + f) * SZ_W13T), D, D};
                pg8::StaticOrder S; S.init(MTOK, 2 * DFF, F.G, (int)blockIdx.x);
                pg8::EpiSwiGLU E{(bf16*)(F.ws + WS_HB), DFF};
                pg8::gemm_phase<pg8::EpiSwiGLU, pg8::StaticOrder, true, true>(F.lds, g, S, E);
            }
            END_STEP();
            if (IN_STEP()) {
                {
                const float* gl = MODL + (6 * f + 2) * D; float* H = (float*)(F.ws + WS_H); bf16* HB = (bf16*)(F.ws + WS_HB);
                { pg8::Gemm g{HB, (const bf16*)(F.ws + WS_W2T + (size_t)(l * 2 + f) * SZ_W2T), DFF, DFF};
                  pg8::StaticOrder S; S.init(SEQ, D, F.G, (int)blockIdx.x);
                  pg8::EpiResid E{H, gl};
                  pg8::gemm_phase<pg8::EpiResid, pg8::StaticOrder, true, true>(F.lds, g, S, E); }
                { pg8::Gemm g{HB + (size_t)SEQ * DFF, (const bf16*)(F.ws + WS_W2T + (size_t)(l * 2 + f) * SZ_W2T), DFF, 512};
                  pg8::SplitKOrder S{8, DFF / 512, 512, F.G, (int)blockIdx.x};
                  pg8::EpiSlab E{(float*)(F.ws + WS_SLAB), gl + NMODV, 512};
                  pg8::gemm_phase<pg8::EpiSlab, pg8::SplitKOrder, true, true>(F.lds, g, S, E); }
                }
            }
            END_STEP();
            if (f == 0) {
                if (IN_STEP()) for (int rp = 0; rp < REP_NORM; ++rp) norm_phase(F, F.in[I_NORMG] + (size_t)(l * 3 + 1) * D, MODL, 3, 4, MTOK, 11);
                END_STEP();
                if (IN_STEP()) for (int rp = 0; rp < REP_G3; ++rp) {
                    pg8::Gemm g{(const bf16*)(F.ws + WS_ABUF), (const bf16*)(F.ws + WS_WINT + (size_t)l * SZ_WINT), D, D};
                    pg8::StaticOrder S; S.init(MTOK, DINP, F.G, (int)blockIdx.x);
                    pg8::EpiWin E{(bf16*)(F.ws + WS_P), (float*)(F.ws + WS_GATES), F.in[I_GATEB] + (size_t)l * 32};
                    pg8::gemm_phase<pg8::EpiWin, pg8::StaticOrder, true, true>(F.lds, g, S, E);
                }
                END_STEP();
                if (IN_STEP()) for (int rp = 0; rp < REP_PREP; ++rp) prep_phase(F, l);
                END_STEP();
                if (IN_STEP()) for (int rp = 0; rp < REP_LOC; ++rp) {
                    LAS float* wsl = (LAS float*)(F.lds + F.wave * 16384);
                    for (int u = blockIdx.x; u < NCHUNK * 8; u += F.G) mlstm_local_unit(F, u >> 3, u & 7, wsl);
                    for (int v = ((int)blockIdx.x + F.G - (NCHUNK * 8) % F.G) % F.G; v < NCHUNK * 4; v += F.G) sgu_unit(F, l, v >> 2, v & 3);
                }
                END_STEP();
                if (IN_STEP()) for (int rp = 0; rp < REP_SCAN; ++rp) scan_phase(F);
                END_STEP();
                if (IN_STEP()) for (int rp = 0; rp < REP_OUT; ++rp) {
                    const float* rpb = F.in[I_RPB] + (size_t)l * 8 * 15 * 31;
                    LAS float* wsl = (LAS float*)(F.lds + F.wave * 16384);
                    for (int u = blockIdx.x; u < NCHUNK * 8; u += F.G) mlstm_out_unit(F, l, u >> 3, u & 7, wsl);
                    for (int v = ((int)blockIdx.x + F.G - (NCHUNK * 8) % F.G) % F.G; v < 512; v += F.G) { const int r = v >> 2, hp = v & 3;
                        na_wave<true>(F, rpb, r * 64 + 16 * (F.wave & 3), 2 * hp + (F.wave >> 2), r, F.wave & 3, F.lane); }
                    for (int v = ((int)blockIdx.x + F.G - (NCHUNK * 8 + 512) % F.G) % F.G; v < 16; v += F.G) { const int wi = v * 8 + F.wave;
                        na_wave<false>(F, rpb, SEQ + 16 * (wi >> 3), wi & 7, 0, 0, F.lane); }
                }
                END_STEP();
                if (IN_STEP()) {
                    const float* gl = MODL + 5 * D; float* H = (float*)(F.ws + WS_H); bf16* CAT = (bf16*)(F.ws + WS_CAT);
                    { pg8::Gemm g{CAT, (const bf16*)(F.ws + WS_WOUTT + (size_t)l * SZ_WOUTT), D, D};
                      pg8::StaticOrder S; S.init(SEQ, D, F.G, (int)blockIdx.x);
                      pg8::EpiResid E{H, gl};
                      pg8::gemm_phase<pg8::EpiResid, pg8::StaticOrder, true, true>(F.lds, g, S, E); }
                    { pg8::Gemm g{CAT + (size_t)SEQ * D, (const bf16*)(F.ws + WS_WOUTT + (size_t)l * SZ_WOUTT), D, 512};
                      pg8::SplitKOrder S{8, D / 512, 512, F.G, (int)blockIdx.x};
                      pg8::EpiSlab E{(float*)(F.ws + WS_SLAB), gl + NMODV, 512};
                      pg8::gemm_phase<pg8::EpiSlab, pg8::SplitKOrder, true, true>(F.lds, g, S, E); }
                }
                END_STEP();
            }
        }
    }
    if (IN_STEP()) final_norm_phase(F);
#undef MODL
#undef IN_STEP
#undef END_STEP
}
constexpr int N_STEPS = 1 + DEPTH * 13 + 1;

extern "C" void kernel_launch(void* const* d_in, const int* in_sizes, int n_in, void* d_out, int out_size, void* d_ws, size_t ws_size, hipStream_t stream) {
    static int grid = 0;
    if (grid == 0) {
        if (n_in != 22 || out_size != SEQ * D || ws_size < WS_END) { fprintf(stderr, "kernel_launch: unexpected shapes (n_in %d, out %d, ws %zu < %zu)\n", n_in, out_size, ws_size, (size_t)WS_END); grid = -1; return; }
        int dev = 0, cus = 0, per_cu = 0;
        if (hipGetDevice(&dev) != hipSuccess || hipDeviceGetAttribute(&cus, hipDeviceAttributeMultiprocessorCount, dev) != hipSuccess) { grid = -1; return; }
        if (hipFuncSetAttribute((const void*)mk_fwd, hipFuncAttributeMaxDynamicSharedMemorySize, LDS_BYTES) != hipSuccess) { fprintf(stderr, "kernel_launch: hipFuncSetAttribute failed\n"); grid = -1; return; }
        if (hipOccupancyMaxActiveBlocksPerMultiprocessor(&per_cu, (const void*)mk_fwd, NTHR, LDS_BYTES) != hipSuccess || per_cu < 1) fprintf(stderr, "kernel_launch: occupancy query says %d\n", per_cu);
        (void)hipGetLastError();
        grid = cus;
    }
    if (grid < 0) return;
    (void)hipMemsetAsync((char*)d_ws + WS_CTL, 0, CTL_ZERO_BYTES, stream);
    Args a{};
    for (int i = 0; i < 22; ++i) a.in[i] = (const float*)d_in[i];
    a.out = (float*)d_out; a.ws = (unsigned char*)d_ws;
#if MK_SPLIT
    for (int s = 0; s < N_STEPS; ++s) { a.step_lo = s; a.step_hi = s + 1; hipLaunchKernelGGL(mk_fwd, dim3(grid), dim3(NTHR), LDS_BYTES, stream, a); }
#else
    a.step_lo = 0; a.step_hi = N_STEPS;
    hipLaunchKernelGGL(mk_fwd, dim3(grid), dim3(NTHR), LDS_BYTES, stream, a);
#endif
    const hipError_t le = hipPeekAtLastError();
    if (le != hipSuccess) fprintf(stderr, "kernel_launch: launch failed: %s\n", hipGetErrorName(le));
}
```

```cpp
#include <hip/hip_runtime.h>
#include <cstdio>
#include <cstdint>

#ifndef MK_SPLIT
#define MK_SPLIT 0
#endif

#ifndef REP_PRO
#define REP_PRO 1
#endif
#ifndef REP_NORM
#define REP_NORM 1
#endif
#ifndef REP_G1
#define REP_G1 1
#endif
#ifndef REP_MO
#define REP_MO 1
#endif
#ifndef REP_NA
#define REP_NA 1
#endif
#ifndef REP_G3
#define REP_G3 1
#endif
#ifndef REP_PREP
#define REP_PREP 1
#endif
#ifndef REP_LOC
#define REP_LOC 1
#endif
#ifndef REP_SCAN
#define REP_SCAN 1
#endif
#ifndef REP_OUT
#define REP_OUT 1
#endif
#define GAS __attribute__((address_space(1)))
#define LAS __attribute__((address_space(3)))

namespace pg8 {
#define PG8_LAS __attribute__((address_space(3)))
typedef unsigned short bf16_t;
typedef short bf16x8 __attribute__((ext_vector_type(8)));
typedef float f32x4 __attribute__((ext_vector_type(4)));
typedef unsigned u32x4 __attribute__((ext_vector_type(4)));
constexpr int BM = 256, BK = 64, HALF = 128, HTB = HALF * BK * 2  , STAGE_BYTES = 8 * HTB, NXCD = 8, WGM = 8;

__host__ __device__ __forceinline__ int lds_byte(int r, int c) { const int st = (r >> 4) * 2 + (c >> 5), rr = r & 15, cc = c & 31, ob = rr * 64 + cc * 2; return st * 1024 + (ob ^ (((ob >> 9) & 1) << 5)); }
__host__ __device__ __forceinline__ void stage_rc(int b, int& R, int& C) { const int st = b / 1024, sb = b % 1024, swz = sb ^ (((sb >> 9) & 1) << 5); R = (st >> 1) * 16 + swz / 64; C = (st & 1) * 32 + (swz % 64) / 2; }
__host__ __device__ __forceinline__ int perm32(int rho) { const int n = rho >> 4, i = rho & 15; return 8 * (i >> 2) + 4 * n + (i & 3); }

struct Unit { int pm, pn, koff; };
struct Gemm { const bf16_t* A; const bf16_t* Bt; int ld, K; };

struct StaticOrder {
    int nM, nN, nwg, G, c;
    __host__ __device__ void init(int M, int N, int G_, int c_) { nM = M / BM; nN = N / BM; nwg = nM * nN; G = G_; c = c_; }
    __host__ __device__ bool next(int i, Unit& u) const {
        const long L = (long)i * G + c; if (L >= nwg) return false;
        int wgid = (int)L; { const int q = nwg / NXCD, r = nwg % NXCD, xcd = wgid % NXCD, off = wgid / NXCD; wgid = (xcd < r ? xcd * (q + 1) : r * (q + 1) + (xcd - r) * q) + off; }
        const int nig = WGM * nN, gid = wgid / nig, fm = gid * WGM, gsz = (nM - fm) < WGM ? (nM - fm) : WGM;
        u.pm = fm + ((wgid % nig) % gsz); u.pn = (wgid % nig) / gsz; u.koff = 0; return true;
    }
    __device__ __forceinline__ void a_ready(const Unit&) const {}
    __device__ __forceinline__ void done(const Unit&) const {}
};
struct SplitKOrder {
    int nN, nK, kslice, G, c;
    __host__ __device__ bool next(int i, Unit& u) const {
        const long L = (long)i * G + c; if (L >= (long)nN * nK) return false;
        u.pm = 0; u.pn = (int)(L % nN); u.koff = (int)(L / nN) * kslice; return true;
    }
    __device__ __forceinline__ void a_ready(const Unit&) const {}
    __device__ __forceinline__ void done(const Unit&) const {}
};

__device__ __forceinline__ unsigned cvt_pk_bf16(float lo, float hi) { unsigned r; asm volatile("v_cvt_pk_bf16_f32 %0, %1, %2" : "=v"(r) : "v"(lo), "v"(hi)); return r; }
__device__ __forceinline__ float silu_f(float a) { return a * __builtin_amdgcn_rcpf(1.0f + __expf(-a)); }

struct EpiSwiGLU {
    static constexpr bool PERM = true, AFTER_DRAIN = false;
    bf16_t* O; int ldc;
    __device__ __forceinline__ void operator()(const f32x4 (&acc)[2][2][4][2], const Unit& u, int wr, int wc, int fr, int fq) const {
        const int row0 = u.pm * BM + wr * 64 + fr, col0 = u.pn * HALF + wc * 32 + 8 * fq;
#pragma unroll
        for (int ai = 0; ai < 2; ++ai)
#pragma unroll
            for (int m = 0; m < 4; ++m) { bf16_t* rowp = O + (size_t)(row0 + ai * HALF + m * 16) * ldc + col0;
                const f32x4 a0 = acc[ai][0][m][0], a1 = acc[ai][0][m][1], g0 = acc[ai][1][m][0], g1 = acc[ai][1][m][1];
                u32x4 w; w.x = cvt_pk_bf16(silu_f(a0[0]) * g0[0], silu_f(a0[1]) * g0[1]); w.y = cvt_pk_bf16(silu_f(a0[2]) * g0[2], silu_f(a0[3]) * g0[3]);
                w.z = cvt_pk_bf16(silu_f(a1[0]) * g1[0], silu_f(a1[1]) * g1[1]); w.w = cvt_pk_bf16(silu_f(a1[2]) * g1[2], silu_f(a1[3]) * g1[3]);
                *(u32x4*)rowp = w; }
    }
};
struct EpiResid {
    static constexpr bool PERM = false, AFTER_DRAIN = false;
    float* H; const float* gate;
    __device__ __forceinline__ void operator()(const f32x4 (&acc)[2][2][4][2], const Unit& u, int wr, int wc, int fr, int fq) const {
        const int row0 = u.pm * BM + wr * 64 + fr, col0 = u.pn * BM + wc * 32 + 4 * fq;
        f32x4 gv[2][2];
#pragma unroll
        for (int bj = 0; bj < 2; ++bj)
#pragma unroll
            for (int n = 0; n < 2; ++n) gv[bj][n] = *(const f32x4*)(gate + col0 + bj * HALF + n * 16);
#pragma unroll
        for (int ai = 0; ai < 2; ++ai)
#pragma unroll
            for (int m = 0; m < 4; ++m) { float* rowp = H + (size_t)(row0 + ai * HALF + m * 16) * 2048 + col0;
#pragma unroll
                for (int bj = 0; bj < 2; ++bj)
#pragma unroll
                    for (int n = 0; n < 2; ++n) { float* p = rowp + bj * HALF + n * 16; *(f32x4*)p = *(const f32x4*)p + gv[bj][n] * acc[ai][bj][m][n]; }
                asm volatile("" ::: "memory"); }
    }
};
struct EpiSlab {
    static constexpr bool PERM = false, AFTER_DRAIN = false;
    float* SLAB; const float* gate; int kslice;
    __device__ __forceinline__ void operator()(const f32x4 (&acc)[2][2][4][2], const Unit& u, int wr, int wc, int fr, int fq) const {
        const int row0 = wr * 64 + fr, col0 = u.pn * BM + wc * 32 + 4 * fq;
        float* base = SLAB + (size_t)(u.koff / kslice) * 256 * 2048;
        f32x4 gv[2][2];
#pragma unroll
        for (int bj = 0; bj < 2; ++bj)
#pragma unroll
            for (int n = 0; n < 2; ++n) gv[bj][n] = *(const f32x4*)(gate + col0 + bj * HALF + n * 16);
#pragma unroll
        for (int ai = 0; ai < 2; ++ai)
#pragma unroll
            for (int m = 0; m < 4; ++m) { float* rowp = base + (size_t)(row0 + ai * HALF + m * 16) * 2048 + col0;
#pragma unroll
                for (int bj = 0; bj < 2; ++bj)
#pragma unroll
                    for (int n = 0; n < 2; ++n) *(f32x4*)(rowp + bj * HALF + n * 16) = gv[bj][n] * acc[ai][bj][m][n]; }
    }
};
struct EpiWin {
    static constexpr bool PERM = true, AFTER_DRAIN = false;
    bf16_t* P; float* GATES; const float* gate_b;
    __device__ __forceinline__ void operator()(const f32x4 (&acc)[2][2][4][2], const Unit& u, int wr, int wc, int fr, int fq) const {
        const int row0 = u.pm * BM + wr * 64 + fr;
        if (u.pn < 26) {
            const int col0 = u.pn * BM + wc * 32 + 8 * fq;
#pragma unroll
            for (int ai = 0; ai < 2; ++ai)
#pragma unroll
                for (int m = 0; m < 4; ++m) { bf16_t* rowp = P + (size_t)(row0 + ai * HALF + m * 16) * 6912 + col0;
#pragma unroll
                    for (int bj = 0; bj < 2; ++bj) { const f32x4 v0 = acc[ai][bj][m][0], v1 = acc[ai][bj][m][1];
                        u32x4 w; w.x = cvt_pk_bf16(v0[0], v0[1]); w.y = cvt_pk_bf16(v0[2], v0[3]); w.z = cvt_pk_bf16(v1[0], v1[1]); w.w = cvt_pk_bf16(v1[2], v1[3]);
                        *(u32x4*)(rowp + bj * HALF) = w; } }
        } else if (wc == 0) {
            const f32x4 b0 = *(const f32x4*)(gate_b + 8 * fq), b1 = *(const f32x4*)(gate_b + 8 * fq + 4);
#pragma unroll
            for (int ai = 0; ai < 2; ++ai)
#pragma unroll
                for (int m = 0; m < 4; ++m) { float* rowp = GATES + (size_t)(row0 + ai * HALF + m * 16) * 32 + 8 * fq;
                    *(f32x4*)rowp = acc[ai][0][m][0] + b0; *(f32x4*)(rowp + 4) = acc[ai][0][m][1] + b1; }
        }
    }
};

template <class Epi, class Sched, bool ALIGN_EPI = false, bool SP2 = false>
__device__ __forceinline__ void gemm_phase(PG8_LAS unsigned char* lds, const Gemm g, const Sched& S, const Epi& E) {
    int tid_ = threadIdx.x; asm volatile("" : "+v"(tid_));
    const int tid = tid_, wid = __builtin_amdgcn_readfirstlane(tid >> 6), lane = tid & 63, wr = wid >> 2, wc = wid & 3, fr = lane & 15, fq = lane >> 4;
    const int ld = g.ld; int nt = g.K / BK; asm volatile("" : "+s"(nt));
    unsigned voffA[2], voffB[2];
#pragma unroll
    for (int i = 0; i < 2; ++i) { int R, C; stage_rc(tid * 16 + i * 8192, R, C); const int Rb = Epi::PERM ? ((R & ~31) + perm32(R & 31)) : R;
        voffA[i] = (unsigned)(R * ld + C) * 2u; voffB[i] = (unsigned)(Rb * ld + C) * 2u; }
    const size_t kstep = (size_t)(BK * 2);
    const size_t hstep = (size_t)HALF * ld * 2;
    const size_t tstep = 2 * hstep;
    const unsigned ldsw = (unsigned)wid * 1024u;
    const int aoff = lds_byte(wr * 64 + fr, fq * 8), boff = lds_byte(wc * 32 + fr, fq * 8);
#define PG8_SA(b, h) (((b) * 2 + (h)) * HTB)
#define PG8_SB(b, h) ((4 + (b) * 2 + (h)) * HTB)
#define PG8_STAGE(bufoff, gbase, voff) do { _Pragma("unroll") for (int _i = 0; _i < 2; ++_i) \
        __builtin_amdgcn_global_load_lds((const unsigned*)((const char*)(gbase) + (voff)[_i]), (PG8_LAS unsigned*)(lds + (bufoff) + ldsw + _i * 8192), 16, 0, 0); } while (0)
#define PG8_LDA(dst, b, h) do { _Pragma("unroll") for (int m = 0; m < 4; ++m) _Pragma("unroll") for (int k = 0; k < 2; ++k) dst[m][k] = *(const PG8_LAS bf16x8*)(lds + PG8_SA(b, h) + aoff + m * 2048 + k * 1024); } while (0)
#define PG8_LDB(dst, b, h) do { _Pragma("unroll") for (int n = 0; n < 2; ++n) _Pragma("unroll") for (int k = 0; k < 2; ++k) dst[n][k] = *(const PG8_LAS bf16x8*)(lds + PG8_SB(b, h) + boff + n * 2048 + k * 1024); } while (0)
#define PG8_MMA(ai, bj, At, Bt) do { __builtin_amdgcn_s_setprio(1); _Pragma("unroll") for (int m = 0; m < 4; ++m) _Pragma("unroll") for (int n = 0; n < 2; ++n) _Pragma("unroll") for (int k = 0; k < 2; ++k) \
        acc[ai][bj][m][n] = __builtin_amdgcn_mfma_f32_16x16x32_bf16(Bt[n][k], At[m][k], acc[ai][bj][m][n], 0, 0, 0); __builtin_amdgcn_s_setprio(0); } while (0)
#define PG8_WAIT_V(n) asm volatile("s_waitcnt vmcnt(" #n ")" ::: "memory")
#define PG8_WAIT_L(n) asm volatile("s_waitcnt lgkmcnt(" #n ")" ::: "memory")
#define PG8_BAR __builtin_amdgcn_s_barrier()
#define PG8_SCHED __builtin_amdgcn_sched_barrier(0)
    Unit cur, nxt; int ui = 0;
    if (!S.next(0, cur)) return;
    f32x4 acc[2][2][4][2];
#pragma unroll
    for (int a = 0; a < 2; ++a)
#pragma unroll
        for (int b = 0; b < 2; ++b)
#pragma unroll
            for (int m = 0; m < 4; ++m)
#pragma unroll
                for (int n = 0; n < 2; ++n) acc[a][b][m][n] = (f32x4){0.f, 0.f, 0.f, 0.f};
    bf16x8 At[4][2], B0[2][2], B1[2][2];
    const char* cA = (const char*)g.A + (size_t)cur.pm * tstep + (size_t)cur.koff * 2; const char* cB = (const char*)g.Bt + (size_t)cur.pn * tstep + (size_t)cur.koff * 2;
    S.a_ready(cur);
    if constexpr (SP2) {
        PG8_STAGE(PG8_SB(0, 0), cB, voffB); PG8_STAGE(PG8_SB(0, 1), cB + hstep, voffB); PG8_STAGE(PG8_SA(0, 0), cA, voffA); PG8_STAGE(PG8_SA(0, 1), cA + hstep, voffA);
        if (wr == 1) PG8_BAR;
        PG8_WAIT_V(2); PG8_BAR;
        PG8_STAGE(PG8_SB(1, 0), cB + kstep, voffB); PG8_STAGE(PG8_SA(1, 0), cA + kstep, voffA); PG8_STAGE(PG8_SB(1, 1), cB + hstep + kstep, voffB);
        PG8_WAIT_V(6); PG8_BAR;
    } else {
        PG8_STAGE(PG8_SB(0, 0), cB, voffB); PG8_STAGE(PG8_SA(0, 0), cA, voffA); PG8_STAGE(PG8_SB(0, 1), cB + hstep, voffB); PG8_STAGE(PG8_SA(0, 1), cA + hstep, voffA);
        if (wr == 1) PG8_BAR;
        PG8_WAIT_V(4); PG8_BAR;
        PG8_STAGE(PG8_SB(1, 0), cB + kstep, voffB); PG8_STAGE(PG8_SA(1, 0), cA + kstep, voffA); PG8_STAGE(PG8_SB(1, 1), cB + hstep + kstep, voffB);
        PG8_WAIT_V(6); PG8_BAR;
    }
    for (;;) {
        const bool has_next = S.next(ui + 1, nxt);
        const char* nA = has_next ? (const char*)g.A + (size_t)nxt.pm * tstep + (size_t)nxt.koff * 2 : cA; const char* nB = has_next ? (const char*)g.Bt + (size_t)nxt.pn * tstep + (size_t)nxt.koff * 2 : cB;
        for (int t = 0; t < nt; t += 2) {
            const bool last = (t == nt - 2);
            const char* a1 = cA + (size_t)(t + 1) * kstep;
            const char* a2 = last ? nA : cA + (size_t)(t + 2) * kstep; const char* b2 = last ? nB : cB + (size_t)(t + 2) * kstep;
            const char* a3 = a2 + kstep; const char* b3 = b2 + kstep;
            if (last && has_next) S.a_ready(nxt);
            if constexpr (SP2) {
            PG8_LDB(B0, 0, 0); PG8_LDB(B1, 0, 1); PG8_SCHED; PG8_LDA(At, 0, 0); PG8_STAGE(PG8_SA(1, 1), a1 + hstep, voffA);
            PG8_WAIT_V(8); PG8_WAIT_L(0); PG8_BAR; PG8_MMA(0, 0, At, B0); PG8_MMA(0, 1, At, B1); PG8_BAR; PG8_SCHED;
            PG8_LDA(At, 0, 1); PG8_STAGE(PG8_SB(0, 0), b2, voffB); PG8_STAGE(PG8_SB(0, 1), b2 + hstep, voffB); PG8_STAGE(PG8_SA(0, 0), a2, voffA);
            PG8_WAIT_V(8); PG8_WAIT_L(0); PG8_BAR; PG8_MMA(1, 0, At, B0); PG8_MMA(1, 1, At, B1); PG8_BAR; PG8_SCHED;
            PG8_LDB(B0, 1, 0); PG8_LDB(B1, 1, 1); PG8_SCHED; PG8_LDA(At, 1, 0); PG8_STAGE(PG8_SA(0, 1), a2 + hstep, voffA);
            PG8_WAIT_V(8); PG8_WAIT_L(0); PG8_BAR; PG8_MMA(0, 0, At, B0); PG8_MMA(0, 1, At, B1); PG8_BAR; PG8_SCHED;
            PG8_LDA(At, 1, 1); PG8_STAGE(PG8_SB(1, 0), b3, voffB); PG8_STAGE(PG8_SB(1, 1), b3 + hstep, voffB); PG8_STAGE(PG8_SA(1, 0), a3, voffA);
            PG8_WAIT_V(8); PG8_WAIT_L(0); PG8_BAR; PG8_MMA(1, 0, At, B0); PG8_MMA(1, 1, At, B1); PG8_BAR; PG8_SCHED;
            } else {
            PG8_LDB(B0, 0, 0); PG8_SCHED; PG8_LDA(At, 0, 0); PG8_STAGE(PG8_SA(1, 1), a1 + hstep, voffA);
            PG8_WAIT_L(8); PG8_BAR; PG8_WAIT_L(0); PG8_MMA(0, 0, At, B0); PG8_BAR; PG8_SCHED;
            PG8_LDB(B1, 0, 1); PG8_STAGE(PG8_SB(0, 0), b2, voffB);
            PG8_BAR; PG8_WAIT_L(0); PG8_MMA(0, 1, At, B1); PG8_BAR;
            PG8_LDA(At, 0, 1); PG8_STAGE(PG8_SA(0, 0), a2, voffA);
            PG8_BAR; PG8_WAIT_L(0); PG8_MMA(1, 0, At, B0); PG8_BAR; PG8_SCHED;
            PG8_STAGE(PG8_SB(0, 1), b2 + hstep, voffB);
            PG8_WAIT_V(6); PG8_BAR; PG8_MMA(1, 1, At, B1); PG8_BAR;
            PG8_LDB(B0, 1, 0); PG8_SCHED; PG8_LDA(At, 1, 0); PG8_STAGE(PG8_SA(0, 1), a2 + hstep, voffA);
            PG8_WAIT_L(8); PG8_BAR; PG8_WAIT_L(0); PG8_MMA(0, 0, At, B0); PG8_BAR; PG8_SCHED;
            PG8_LDB(B1, 1, 1); PG8_STAGE(PG8_SB(1, 0), b3, voffB);
            PG8_BAR; PG8_WAIT_L(0); PG8_MMA(0, 1, At, B1); PG8_BAR;
            PG8_LDA(At, 1, 1); PG8_STAGE(PG8_SA(1, 0), a3, voffA);
            PG8_BAR; PG8_WAIT_L(0); PG8_MMA(1, 0, At, B0); PG8_BAR; PG8_SCHED;
            PG8_STAGE(PG8_SB(1, 1), b3 + hstep, voffB);
            PG8_WAIT_V(6); PG8_BAR; PG8_MMA(1, 1, At, B1); PG8_BAR;
            }
        }
        if constexpr (ALIGN_EPI) { if (wr == 0) PG8_BAR; }
        if constexpr (!Epi::AFTER_DRAIN) { E(acc, cur, wr, wc, fr, fq); S.done(cur); }
        if (!has_next) break;
#pragma unroll
        for (int a = 0; a < 2; ++a)
#pragma unroll
            for (int b = 0; b < 2; ++b)
#pragma unroll
                for (int m = 0; m < 4; ++m)
#pragma unroll
                    for (int n = 0; n < 2; ++n) acc[a][b][m][n] = (f32x4){0.f, 0.f, 0.f, 0.f};
        cur = nxt; cA = nA; cB = nB; ++ui;
        if constexpr (ALIGN_EPI) { if (wr == 1) PG8_BAR; }
    }
    PG8_WAIT_V(0);
    if constexpr (!ALIGN_EPI) { if (wr == 0) PG8_BAR; }
    PG8_BAR;
#undef PG8_SA
#undef PG8_SB
#undef PG8_STAGE
#undef PG8_LDA
#undef PG8_LDB
#undef PG8_MMA
#undef PG8_WAIT_V
#undef PG8_WAIT_L
#undef PG8_BAR
#undef PG8_SCHED
}
}

constexpr int D = 2048, SEQ = 8192, CTXL = 256, MTOK = SEQ + CTXL, DEPTH = 4, DFF = 5632, NMODV = 9 * D;
constexpr int DIN = 6688, DINP = 6912;
constexpr int NCHUNK = 66;
constexpr float EPS = 1e-6f;
constexpr int NWAVES = 8, NTHR = 512;
constexpr int PC_U = 0, PC_V = 512, PC_MQ = 1024, PC_MK = 2048, PC_MV = 3072, PC_MO = 4096, PC_NQ = 5120, PC_NK = 5632, PC_NV = 6144;

constexpr size_t MiB = 1u << 20;
constexpr size_t WS_CTL = 0, CTL_ZERO_BYTES = 1 * MiB;
constexpr size_t WS_MOD = 1 * MiB;
constexpr size_t WS_ROPE = 2 * MiB;
constexpr size_t WS_SGW = 3 * MiB;
constexpr size_t SZ_W13T = (size_t)2 * DFF * D * 2, SZ_W2T = (size_t)D * DFF * 2, SZ_WINT = (size_t)DINP * D * 2, SZ_WOUTT = (size_t)D * D * 2;
constexpr size_t WS_W13T = 4 * MiB;
constexpr size_t WS_W2T = WS_W13T + 8 * SZ_W13T;
constexpr size_t WS_WINT = WS_W2T + 8 * SZ_W2T;
constexpr size_t WS_WOUTT = WS_WINT + 4 * SZ_WINT;
constexpr size_t WS_H = WS_WOUTT + 4 * SZ_WOUTT;
constexpr size_t WS_ABUF = WS_H + (size_t)MTOK * D * 4;
constexpr size_t WS_CAT = WS_ABUF + (size_t)MTOK * D * 2;
constexpr size_t WS_HB = WS_CAT + (size_t)MTOK * D * 2;
constexpr size_t WS_P = WS_HB + (size_t)MTOK * DFF * 2;
constexpr size_t WS_GATES = WS_P + (size_t)MTOK * DINP * 2;
constexpr size_t WS_QC = WS_GATES + (size_t)MTOK * 32 * 4;
constexpr size_t WS_KC = WS_QC + (size_t)MTOK * 1024 * 2;
constexpr size_t WS_KCT = WS_KC + (size_t)MTOK * 1024 * 2;
constexpr size_t WS_MVT = WS_KCT + (size_t)MTOK * 1024 * 2;
constexpr size_t WS_NAVT = WS_MVT + (size_t)MTOK * 1024 * 2;
constexpr size_t WS_VNT = WS_NAVT + (size_t)MTOK * 512 * 2;
constexpr size_t WS_UT = WS_VNT + (size_t)MTOK * 512 * 2;
constexpr size_t WS_UN = WS_UT + (size_t)2 * NCHUNK * 8 * 128 * 128 * 4;
constexpr size_t WS_BLGM = WS_UN + (size_t)2 * NCHUNK * 8 * 128 * 4;
constexpr size_t WS_CT = WS_BLGM + 1 * MiB;
constexpr size_t WS_CN = WS_CT + (size_t)2 * NCHUNK * 8 * 128 * 128 * 2;
constexpr size_t WS_CM = WS_CN + (size_t)2 * NCHUNK * 8 * 128 * 4;
constexpr size_t WS_SLAB = WS_CM + 1 * MiB;
constexpr size_t WS_END = WS_SLAB + (size_t)11 * 256 * 2048 * 4;

constexpr int RING_BYTES = 131072, LDSCTL_OFF = 143360, LDS_BYTES = 147456;

typedef unsigned short bf16;
typedef short bf16x8 __attribute__((ext_vector_type(8)));
typedef short bf16x4 __attribute__((ext_vector_type(4)));
typedef float f32x4 __attribute__((ext_vector_type(4)));
typedef float f32x2 __attribute__((ext_vector_type(2)));
typedef unsigned u32x4 __attribute__((ext_vector_type(4)));
typedef unsigned u32x2 __attribute__((ext_vector_type(2)));
typedef __bf16 bf16x2_t __attribute__((ext_vector_type(2)));
typedef GAS unsigned gu32;
#define RLX_AGENT __ATOMIC_RELAXED, __HIP_MEMORY_SCOPE_AGENT
#define LDS_FENCE() asm volatile("s_waitcnt lgkmcnt(0)" ::: "memory")

__device__ __forceinline__ float bf2f(short b) { return __uint_as_float(((unsigned)(unsigned short)b) << 16); }
__device__ __forceinline__ unsigned pk2(float lo, float hi) { f32x2 v = {lo, hi}; bf16x2_t b = __builtin_convertvector(v, bf16x2_t); return __builtin_bit_cast(unsigned, b); }
__device__ __forceinline__ short f2bf(float f) { return (short)(pk2(f, 0.f) & 0xffffu); }
__device__ __forceinline__ bf16x4 pk4(float a, float b, float c, float d) { u32x2 w; w.x = pk2(a, b); w.y = pk2(c, d); return __builtin_bit_cast(bf16x4, w); }
__device__ __forceinline__ bf16x8 cat8(bf16x4 lo, bf16x4 hi) { return __builtin_shufflevector(lo, hi, 0, 1, 2, 3, 4, 5, 6, 7); }
__device__ __forceinline__ f32x4 mfma16(bf16x8 a, bf16x8 b, f32x4 c) { return __builtin_amdgcn_mfma_f32_16x16x32_bf16(a, b, c, 0, 0, 0); }
__device__ __forceinline__ float wsum(float v) {
#pragma unroll
    for (int o = 1; o < 64; o <<= 1) v += __shfl_xor(v, o);
    return v; }
__device__ __forceinline__ float wmax(float v) {
#pragma unroll
    for (int o = 1; o < 64; o <<= 1) v = fmaxf(v, __shfl_xor(v, o));
    return v; }
__device__ __forceinline__ float qsum(float v) { v += __shfl_xor(v, 16); v += __shfl_xor(v, 32); return v; }
__device__ __forceinline__ float qmax(float v) { v = fmaxf(v, __shfl_xor(v, 16)); v = fmaxf(v, __shfl_xor(v, 32)); return v; }
__device__ __forceinline__ float scan_up_add(float v, int lane) {
#pragma unroll
    for (int o = 1; o < 64; o <<= 1) { const float t = __shfl_up(v, o); if (lane >= o) v += t; }
    return v; }
__device__ __forceinline__ float scan_down_add(float v, int lane) {
#pragma unroll
    for (int o = 1; o < 64; o <<= 1) { const float t = __shfl_down(v, o); if (lane + o < 64) v += t; }
    return v; }
__device__ __forceinline__ float scan_up_max(float v, int lane) {
#pragma unroll
    for (int o = 1; o < 64; o <<= 1) { const float t = __shfl_up(v, o); if (lane >= o) v = fmaxf(v, t); }
    return v; }
__device__ __forceinline__ float scan_down_max(float v, int lane) {
#pragma unroll
    for (int o = 1; o < 64; o <<= 1) { const float t = __shfl_down(v, o); if (lane + o < 64) v = fmaxf(v, t); }
    return v; }
__device__ __forceinline__ float sigmoid_f(float a) { return __builtin_amdgcn_rcpf(1.0f + __expf(-a)); }
__device__ __forceinline__ float silu_f(float a) { return a * sigmoid_f(a); }
__device__ __forceinline__ float gelu_tanh(float x) { const float u = 1.5957691216057308f * (x + 0.044715f * x * x * x); return x * sigmoid_f(u); }
__device__ __forceinline__ float logsig(float x) { return fminf(x, 0.f) - log1pf(__expf(-fabsf(x))); }

#define XB_TMO      128
#define XB_XCNT(j)  (256  + 64 * (j))
#define XB_XSUB(j)  (1280 + 64 * (j))
#define XB_XGEN(j)  (2304 + 64 * (j))
#define XB_TOP      3328
#define XB_TOPGEN   3392
#define XCD_BAR_WORDS 3456
#define XB_SPIN_CAP (1u << 20)
__device__ __forceinline__ unsigned xb_ld(unsigned* p)              { return __hip_atomic_load(p, __ATOMIC_RELAXED, __HIP_MEMORY_SCOPE_AGENT); }
__device__ __forceinline__ unsigned xb_add(unsigned* p, unsigned v) { return __hip_atomic_fetch_add(p, v, __ATOMIC_RELAXED, __HIP_MEMORY_SCOPE_AGENT); }
__device__ __forceinline__ unsigned xb_xcc_id() { return (unsigned)__builtin_amdgcn_s_getreg((3 << 11) | 20) & 0xFu; }
#define XB_SPIN(cond, bar) do { unsigned _sp = 0; while (cond) { __builtin_amdgcn_s_sleep(1); \
    if ((++_sp & 255u) == 0u) { if (xb_ld(&(bar)[XB_TMO])) break; if (_sp > XB_SPIN_CAP) { atomicAdd(&(bar)[XB_TMO], 1u); break; } } } } while (0)
struct XcdBarrier { unsigned* bar; unsigned x; volatile LAS unsigned* st; };
__device__ __forceinline__ XcdBarrier xcd_barrier_post(unsigned* bar, volatile LAS unsigned* st) {
    XcdBarrier b; b.bar = bar; b.x = xb_xcc_id(); b.st = st;
    if (threadIdx.x == 0) (void)xb_add(&bar[XB_XCNT(b.x)], 1u);
    return b;
}
__device__ __forceinline__ void xcd_barrier_complete(unsigned* bar, unsigned x, unsigned& nloc, unsigned& nx) {
    const unsigned G = gridDim.x * gridDim.y * gridDim.z;
    unsigned sum, cnt, mine, sp = 0u;
    for (;;) {
        sum = 0u; cnt = 0u; mine = 0u;
#pragma unroll
        for (unsigned j = 0; j < 16; ++j) { const unsigned c = xb_ld(&bar[XB_XCNT(j)]); sum += c; cnt += (c > 0u) ? 1u : 0u; mine = (j == x) ? c : mine; }
        if (sum == G) break;
        __builtin_amdgcn_s_sleep(1);
        if ((++sp & 255u) == 0u) { if (xb_ld(&bar[XB_TMO])) break; if (sp > XB_SPIN_CAP) { atomicAdd(&bar[XB_TMO], 1u); break; } }
    }
    nloc = mine > 0u ? mine : 1u; nx = cnt > 0u ? cnt : 1u;
}
__device__ __forceinline__ void xcd_barrier(const XcdBarrier& b) {
    asm volatile("s_waitcnt vmcnt(0)" ::: "memory");
    __syncthreads();
    if (threadIdx.x == 0) {
        unsigned* bar = b.bar;
        __builtin_amdgcn_s_waitcnt(0);
        unsigned nloc = b.st[0], nx = b.st[1];
        if (nloc == 0u) { xcd_barrier_complete(bar, b.x, nloc, nx); b.st[0] = nloc; b.st[1] = nx; }
        const unsigned old = xb_add(&bar[XB_XSUB(b.x)], 1u);
        const unsigned gen = old / nloc;
        if (old + 1u == (gen + 1u) * nloc) {
            __builtin_amdgcn_fence(__ATOMIC_RELEASE, "agent");
            asm volatile("s_waitcnt vmcnt(0)" ::: "memory");
            const unsigned og = xb_add(&bar[XB_TOP], 1u);
            const unsigned tg = og / nx;
            if (og + 1u == (tg + 1u) * nx) xb_add(&bar[XB_TOPGEN], 1u);
            else XB_SPIN(xb_ld(&bar[XB_TOPGEN]) == tg, bar);
            __builtin_amdgcn_fence(__ATOMIC_ACQUIRE, "agent");
            xb_add(&bar[XB_XGEN(b.x)], 1u);
            asm volatile("s_waitcnt vmcnt(0)" ::: "memory");
        } else {
            XB_SPIN(xb_ld(&bar[XB_XGEN(b.x)]) == gen, bar);
            __builtin_amdgcn_fence(__ATOMIC_ACQUIRE, "agent");
            asm volatile("s_waitcnt vmcnt(0)" ::: "memory");
        }
    }
    __syncthreads();
}

struct Args { const float* in[22]; float* out; unsigned char* ws; int step_lo, step_hi; };

struct Frame {
    LAS unsigned char* lds;
    int tid, lane, wave, G;
    const float* const* in;
    float* out; unsigned char* ws;
};

__device__ __forceinline__ void frame_site(Frame& F, const Args& args) { int t = threadIdx.x; asm volatile("" : "+v"(t)); F.tid = t; F.lane = t & 63; F.wave = __builtin_amdgcn_readfirstlane(t >> 6);
    int z; asm volatile("s_mov_b32 %0, 0" : "=s"(z));
    F.in = args.in + z; F.ws = args.ws + z; F.out = args.out + z; }
__device__ __forceinline__ void frame_tid(Frame& F) { int t = threadIdx.x; asm volatile("" : "+v"(t)); F.tid = t; F.lane = t & 63; F.wave = __builtin_amdgcn_readfirstlane(t >> 6); }
enum { I_X = 0, I_C, I_CTX, I_CCTX, I_ADAW, I_ADAB, I_NORMG, I_F1W13, I_F1W2, I_F2W13, I_F2W2, I_WIN, I_WOUT, I_SGNG, I_SGW, I_SGB, I_CONVW, I_CONVB, I_GATEB, I_MNG, I_RPB, I_FNG };

__device__ __forceinline__ void p0_transpose_item(const float* W, int K, int N, bf16* WT, int k0, int n0, int dst_row0, LAS float* scr, int lane) {
#pragma unroll 8
    for (int i = 0; i < 32; ++i) { const int kk = 2 * i + (lane >> 5); scr[kk * 33 + (lane & 31)] = W[(size_t)(k0 + kk) * N + n0 + (lane & 31)]; }
    LDS_FENCE();
    const int c = lane & 7;
#pragma unroll
    for (int j = 0; j < 4; ++j) { const int n = (lane >> 3) + 8 * j; const LAS float* s = scr + (8 * c) * 33 + n;
        u32x4 o; o.x = pk2(s[0 * 33], s[1 * 33]); o.y = pk2(s[2 * 33], s[3 * 33]); o.z = pk2(s[4 * 33], s[5 * 33]); o.w = pk2(s[6 * 33], s[7 * 33]);
        *(u32x4*)(WT + (size_t)(dst_row0 + n) * K + k0 + 8 * c) = o; }
    LDS_FENCE();
}
__device__ __forceinline__ int w13_dst(int n) { return n < DFF ? (n >> 7) * 256 + (n & 127) : ((n - DFF) >> 7) * 256 + 128 + ((n - DFF) & 127); }
__device__ __forceinline__ int win_dst(int n) { return n < 5120 ? n : (n < 5152 ? 6656 + (n - 5120) : n - 32); }

__device__ __forceinline__ void p0_prologue(Frame& F) {
    const int gw = blockIdx.x * NWAVES + F.wave, NGW = F.G * NWAVES;
    const int gt = blockIdx.x * NTHR + F.tid, NGT = F.G * NTHR;
    { const f32x4* x4 = (const f32x4*)F.in[I_X]; const f32x4* c4 = (const f32x4*)F.in[I_CTX]; f32x4* h4 = (f32x4*)(F.ws + WS_H);
      const int nx = SEQ * D / 4, nc = CTXL * D / 4;
      for (int i = gt; i < nx + nc; i += NGT) h4[i] = i < nx ? x4[i] : c4[i - nx]; }
    { float* rt = (float*)(F.ws + WS_ROPE);
      for (int i = gt; i < 128 * 32; i += NGT) { const int pos = i >> 5, fi = i & 31; const float fr = exp2f(-(float)fi * (13.287712379549449f / 32.0f)); float s, c; sincosf((float)pos * fr, &s, &c); rt[2 * i] = c; rt[2 * i + 1] = s; }
      const float* sw = F.in[I_SGW]; bf16* so = (bf16*)(F.ws + WS_SGW);
      for (int i = gt; i < DEPTH * 4 * 128 * 128 / 2; i += NGT) ((unsigned*)so)[i] = pk2(sw[2 * i], sw[2 * i + 1]); }
    { LAS float* sc = (LAS float*)(F.lds);
      LAS float* red = (LAS float*)(F.lds + 16384);
      for (int i = F.tid; i < 2 * D; i += NTHR) { const float v = i < D ? F.in[I_C][i] : F.in[I_CCTX][i - D]; sc[i] = silu_f(v); }
      __syncthreads();
      for (int it = blockIdx.x; it < DEPTH * 72; it += F.G) {
          const int l = it / 72, cg = it % 72, n0 = cg * 256 + 4 * F.lane;
          const float* W = F.in[I_ADAW] + (size_t)l * D * NMODV + n0;
          f32x4 al = {0.f, 0.f, 0.f, 0.f}, ac = {0.f, 0.f, 0.f, 0.f};
          const int kb = F.wave * 256;
#pragma unroll 8
          for (int k = 0; k < 256; ++k) { const f32x4 w = *(const f32x4*)(W + (size_t)(kb + k) * NMODV); al += w * sc[kb + k]; ac += w * sc[D + kb + k]; }
#pragma unroll
          for (int j = 0; j < 4; ++j) { red[(F.wave * 256 + 4 * F.lane + j) * 2] = al[j]; red[(F.wave * 256 + 4 * F.lane + j) * 2 + 1] = ac[j]; }
          __syncthreads();
          { const int col = F.tid >> 1, t = F.tid & 1; float s = 0.f;
#pragma unroll
            for (int w = 0; w < 8; ++w) s += red[(w * 256 + col) * 2 + t];
            const int n = cg * 256 + col; s += F.in[I_ADAB][l * NMODV + n];
            const int ch = n >> 11; if (ch == 2 || ch == 8) s *= 0.5f;
            ((float*)(F.ws + WS_MOD))[(size_t)(l * 2 + t) * NMODV + n] = s; }
          __syncthreads();
      }
    }
    { LAS float* scr = (LAS float*)(F.lds + F.wave * 16384);
      constexpr int I_13 = 32 * 352, I_2 = 88 * 64, I_IN = 32 * 209, I_OUT = 32 * 64, I_LAYER = 2 * I_13 + 2 * I_2 + I_IN + I_OUT;
      for (int it = gw; it < DEPTH * I_LAYER; it += NGW) {
          const int l = it / I_LAYER; int r = it % I_LAYER;
          if (r < 2 * I_13) { const int f = r / I_13; r %= I_13; const int kb = r / 352, nb = r % 352;
              p0_transpose_item(F.in[f ? I_F2W13 : I_F1W13] + (size_t)l * D * 2 * DFF, D, 2 * DFF, (bf16*)(F.ws + WS_W13T + (size_t)(l * 2 + f) * SZ_W13T), kb * 64, nb * 32, w13_dst(nb * 32), scr, F.lane); continue; }
          r -= 2 * I_13;
          if (r < 2 * I_2) { const int f = r / I_2; r %= I_2; const int kb = r / 64, nb = r % 64;
              p0_transpose_item(F.in[f ? I_F2W2 : I_F1W2] + (size_t)l * DFF * D, DFF, D, (bf16*)(F.ws + WS_W2T + (size_t)(l * 2 + f) * SZ_W2T), kb * 64, nb * 32, nb * 32, scr, F.lane); continue; }
          r -= 2 * I_2;
          if (r < I_IN) { const int kb = r / 209, nb = r % 209;
              p0_transpose_item(F.in[I_WIN] + (size_t)l * D * DIN, D, DIN, (bf16*)(F.ws + WS_WINT + (size_t)l * SZ_WINT), kb * 64, nb * 32, win_dst(nb * 32), scr, F.lane); continue; }
          r -= I_IN;
          { const int kb = r / 64, nb = r % 64;
              p0_transpose_item(F.in[I_WOUT] + (size_t)l * D * D, D, D, (bf16*)(F.ws + WS_WOUTT + (size_t)l * SZ_WOUTT), kb * 64, nb * 32, nb * 32, scr, F.lane); }
      }
    }
}

__device__ __forceinline__ void norm_phase(Frame& F, const float* g, const float* modl  , int ishift, int iscale, int M, int nparts) {
    const int gw = blockIdx.x * NWAVES + F.wave, NGW = F.G * NWAVES;
    float* H = (float*)(F.ws + WS_H); bf16* A = (bf16*)(F.ws + WS_ABUF);
    for (int row = gw; row < M; row += NGW) {
        const int t = row >= SEQ ? 1 : 0;
        const float* sh = modl + (size_t)t * NMODV + ishift * D; const float* scl = modl + (size_t)t * NMODV + iscale * D;
        const f32x4* xr = (const f32x4*)(H + (size_t)row * D) + F.lane;
        f32x4 v[8]; float s = 0.f;
#pragma unroll
        for (int j = 0; j < 8; ++j) v[j] = xr[64 * j];
        if (t && nparts > 0) {
            const f32x4* sl = (const f32x4*)(F.ws + WS_SLAB) + (size_t)(row - SEQ) * (D / 4) + F.lane;
            for (int p = 0; p < nparts; ++p) {
#pragma unroll
                for (int j = 0; j < 8; ++j) v[j] += sl[(size_t)p * 256 * (D / 4) + 64 * j]; }
            f32x4* xw = (f32x4*)(H + (size_t)row * D) + F.lane;
#pragma unroll
            for (int j = 0; j < 8; ++j) xw[64 * j] = v[j];
        }
#pragma unroll
        for (int j = 0; j < 8; ++j) s += (v[j][0] * v[j][0] + v[j][1] * v[j][1]) + (v[j][2] * v[j][2] + v[j][3] * v[j][3]);
        const float rstd = rsqrtf(wsum(s) * (1.0f / D) + EPS);
        u32x2* o = (u32x2*)(A + (size_t)row * D) + F.lane;
#pragma unroll
        for (int j = 0; j < 8; ++j) { const int c = 4 * F.lane + 256 * j;
            const f32x4 gg = *(const f32x4*)(g + c), ss = *(const f32x4*)(scl + c), hh = *(const f32x4*)(sh + c);
            const f32x4 y = (v[j] * rstd) * gg * (ss + 1.0f) + hh;
            u32x2 w; w.x = pk2(y[0], y[1]); w.y = pk2(y[2], y[3]); o[64 * j] = w; }
    }
}
__device__ __forceinline__ void final_norm_phase(Frame& F) {
    const int gw = blockIdx.x * NWAVES + F.wave, NGW = F.G * NWAVES;
    const float* H = (const float*)(F.ws + WS_H); const float* g = F.in[I_FNG];
    for (int row = gw; row < SEQ; row += NGW) {
        const f32x4* xr = (const f32x4*)(H + (size_t)row * D) + F.lane;
        f32x4 v[8]; float s = 0.f;
#pragma unroll
        for (int j = 0; j < 8; ++j) { v[j] = xr[64 * j]; s += (v[j][0] * v[j][0] + v[j][1] * v[j][1]) + (v[j][2] * v[j][2] + v[j][3] * v[j][3]); }
        const float rstd = rsqrtf(wsum(s) * (1.0f / D) + EPS);
        f32x4* o = (f32x4*)(F.out + (size_t)row * D) + F.lane;
#pragma unroll
        for (int j = 0; j < 8; ++j) o[64 * j] = (v[j] * rstd) * *(const f32x4*)(g + 4 * F.lane + 256 * j);
    }
}

__device__ __forceinline__ void tile_rows_out(const LAS short* tile, bf16* dst, int row0, int tokb, int lane) {
    LDS_FENCE();
#pragma unroll
    for (int it = 0; it < 8; ++it) { const int idx = it * 64 + lane, r = idx >> 3, seg = idx & 7;
        const bf16x8 v = *(const LAS bf16x8*)(tile + r * 72 + 8 * seg);
        *(bf16x8*)(dst + (size_t)(row0 + r) * MTOK + tokb + 8 * seg) = v; }
    LDS_FENCE();
}
__device__ __forceinline__ void prep_transpose_item(const bf16* P, int c0, bf16* dst, int drow0, int tb, LAS short* tile, int lane) {
#pragma unroll
    for (int it = 0; it < 8; ++it) { const int idx = it * 64 + lane, tok = idx >> 3, seg = idx & 7;
        const bf16x8 v = *(const bf16x8*)(P + (size_t)(tb * 64 + tok) * DINP + c0 + 8 * seg);
#pragma unroll
        for (int j = 0; j < 8; ++j) tile[(8 * seg + j) * 72 + tok] = v[j]; }
    tile_rows_out(tile, dst, drow0, tb * 64, lane);
}
__device__ __forceinline__ void prep_conv_item(Frame& F, const bf16* P, const float* cw  , const float* cb, int tb, int cg, LAS short* tile, int lane) {
    const int i = lane & 31, ts = lane >> 5, ch0 = cg * 64 + i, ch1 = ch0 + 32;
    const bool isK = cg >= 16; const int half = cg & 1;
    const int tok0 = tb * 64, t0 = tok0 + 32 * ts;
    const int seq_lo = tok0 < SEQ ? 0 : SEQ, seq_hi = tok0 < SEQ ? SEQ : MTOK;
    float w0[5], w1[5];
#pragma unroll
    for (int j = 0; j < 5; ++j) { w0[j] = cw[j * 2048 + ch0]; w1[j] = cw[j * 2048 + ch1]; }
    const float b0 = cb[ch0], b1 = cb[ch1];
    const bf16* src = P + PC_MQ;
    float xa[36], xb[36];
#pragma unroll
    for (int j = 0; j < 36; ++j) { const int t = t0 + j - 2; const bool ok = t >= seq_lo && t < seq_hi;
        xa[j] = ok ? bf2f((short)src[(size_t)t * DINP + ch0]) : 0.f; xb[j] = ok ? bf2f((short)src[(size_t)t * DINP + ch1]) : 0.f; }
    const float* rope = (const float*)(F.ws + WS_ROPE);
    const bool lat = tok0 < SEQ;
    bf16* dstn = (bf16*)(F.ws + (isK ? WS_KC : WS_QC));
    const int chn0 = ch0 & 1023;
    const float qs = isK ? 1.0f : 0.08838834764831845f;
#pragma unroll
    for (int tt = 0; tt < 32; ++tt) {
        const int t = t0 + tt;
        float y0 = b0, y1 = b1;
#pragma unroll
        for (int j = 0; j < 5; ++j) { y0 += w0[j] * xa[tt + j]; y1 += w1[j] * xb[tt + j]; }
        y0 = silu_f(y0); y1 = silu_f(y1);
        if (lat) { const int pos = half ? (t & 63) : (t >> 6); const f32x2 cs2 = *(const f32x2*)(rope + (pos * 32 + i) * 2);
            const float r0 = y0 * cs2[0] - y1 * cs2[1], r1 = y0 * cs2[1] + y1 * cs2[0]; y0 = r0; y1 = r1; }
        y0 *= qs; y1 *= qs;
        const short o0 = f2bf(y0), o1 = f2bf(y1);
        dstn[(size_t)t * 1024 + chn0] = (bf16)o0; dstn[(size_t)t * 1024 + chn0 + 32] = (bf16)o1;
        if (isK) { tile[i * 72 + 32 * ts + tt] = o0; tile[(i + 32) * 72 + 32 * ts + tt] = o1; }
    }
    if (isK) tile_rows_out(tile, (bf16*)(F.ws + WS_KCT), (cg - 16) * 64, tok0, lane);
}
__device__ __forceinline__ void prep_sgu_item(Frame& F, const bf16* P, const float* ng, int tb, int cg, LAS short* tile, int lane) {
    const int tok0 = tb * 64;
    float p[64];
#pragma unroll
    for (int tok = 0; tok < 64; ++tok) {
        const bf16x8 v = *(const bf16x8*)(P + (size_t)(tok0 + tok) * DINP + PC_V + 8 * lane); float sq = 0.f;
#pragma unroll
        for (int j = 0; j < 8; ++j) { const float gl = gelu_tanh(bf2f(v[j])); sq += gl * gl; }
        p[tok] = sq;
    }
#pragma unroll
    for (int o = 32; o >= 1; o >>= 1) {
        const bool up = (lane & o) != 0;
#pragma unroll
        for (int i2 = 0; i2 < o; ++i2) { const float lo_ = p[i2], hi_ = p[i2 + o]; const float send = up ? lo_ : hi_, keep = up ? hi_ : lo_; p[i2] = keep + __shfl_xor(send, o); }
    }
    const float myr = rsqrtf(p[0] * (1.0f / 512.0f) + EPS);
    const bf16* rowp = P + (size_t)(tok0 + lane) * DINP + PC_V + cg * 64;
#pragma unroll
    for (int seg = 0; seg < 8; ++seg) { const bf16x8 v = *(const bf16x8*)(rowp + 8 * seg);
#pragma unroll
        for (int j = 0; j < 8; ++j) tile[(8 * seg + j) * 72 + lane] = f2bf(gelu_tanh(bf2f(v[j])) * myr * ng[cg * 64 + 8 * seg + j]); }
    tile_rows_out(tile, (bf16*)(F.ws + WS_VNT), cg * 64, tok0, lane);
}
__device__ __forceinline__ void prep_phase(Frame& F, int l) {
    const int gw = blockIdx.x * NWAVES + F.wave, NGW = F.G * NWAVES;
    const bf16* P = (const bf16*)(F.ws + WS_P);
    LAS short* tile = (LAS short*)(F.lds + F.wave * 16384);
    constexpr int NTB = MTOK / 64;
    constexpr int N_CONV = NTB * 32, N_SGU = NTB * 8, N_MVT = NTB * 16, N_NAVT = NTB * 8;
    for (int it = gw; it < N_CONV + N_SGU + N_MVT + N_NAVT; it += NGW) {
        int r = it;
        if (r < N_CONV) { prep_conv_item(F, P, F.in[I_CONVW] + (size_t)l * 5 * 2048, F.in[I_CONVB] + (size_t)l * 2048, r >> 5, r & 31, tile, F.lane); continue; } r -= N_CONV;
        if (r < N_SGU) { prep_sgu_item(F, P, F.in[I_SGNG] + (size_t)l * 512, r >> 3, r & 7, tile, F.lane); continue; } r -= N_SGU;
        if (r < N_MVT) { prep_transpose_item(P, PC_MV + (r & 15) * 64, (bf16*)(F.ws + WS_MVT), (r & 15) * 64, r >> 4, tile, F.lane); continue; } r -= N_MVT;
        prep_transpose_item(P, PC_NV + (r & 7) * 64, (bf16*)(F.ws + WS_NAVT), (r & 7) * 64, r >> 3, tile, F.lane);
    }
}

struct MG { float i_f[2], b_f[2], i_b[2], b_b[2]; float bl_f, bl_b; };
__device__ __forceinline__ void mlstm_gates(const float* G, int lane, MG& g) {
    float lf[2], lb[2];
#pragma unroll
    for (int x = 0; x < 2; ++x) { const float* p = G + (size_t)(lane + 64 * x) * 32; g.i_f[x] = p[0]; lf[x] = logsig(p[8]); g.i_b[x] = p[16]; lb[x] = logsig(p[24]); }
    const float s0 = scan_up_add(lf[0], lane), t0 = __shfl(s0, 63), s1 = scan_up_add(lf[1], lane) + t0;
    g.b_f[0] = s0; g.b_f[1] = s1; g.bl_f = __shfl(s1, 63);
    const float r1 = scan_down_add(lb[1], lane), t1 = __shfl(r1, 0), r0 = scan_down_add(lb[0], lane) + t1;
    g.b_b[0] = r0; g.b_b[1] = r1; g.bl_b = __shfl(r0, 0);
}
__device__ __forceinline__ void mlstm_local_unit(Frame& F, int c, int h, LAS float* wsl) {
    const int lane = F.lane, w = F.wave, fr = lane & 15, fq = lane >> 4, tok0 = c * 128;
    const int posf = (c + 2) % NCHUNK, posb = 65 - c;
    MG g; mlstm_gates((const float*)(F.ws + WS_GATES) + (size_t)tok0 * 32 + h, lane, g);
    float gf[2], gb[2];
#pragma unroll
    for (int x = 0; x < 2; ++x) { gf[x] = g.bl_f - g.b_f[x] + g.i_f[x]; gb[x] = g.bl_b - g.b_b[x] + g.i_b[x]; }
    const float gmf = wmax(fmaxf(gf[0], gf[1])), gmb = wmax(fmaxf(gb[0], gb[1]));
    wsl[lane] = __expf(gf[0] - gmf); wsl[64 + lane] = __expf(gf[1] - gmf); wsl[128 + lane] = __expf(gb[0] - gmb); wsl[192 + lane] = __expf(gb[1] - gmb);
    LDS_FENCE();
    const bf16* krow = (const bf16*)(F.ws + WS_KCT) + (size_t)(h * 128 + 16 * w + fr) * MTOK + tok0 + 8 * fq;
    bf16x8 yf[4], yb[4]; float unf = 0.f, unb = 0.f;
#pragma unroll
    for (int ks = 0; ks < 4; ++ks) { const bf16x8 raw = *(const bf16x8*)(krow + 32 * ks);
        const f32x4 wf0 = *(const LAS f32x4*)(wsl + 32 * ks + 8 * fq), wf1 = *(const LAS f32x4*)(wsl + 32 * ks + 8 * fq + 4);
        const f32x4 wb0 = *(const LAS f32x4*)(wsl + 128 + 32 * ks + 8 * fq), wb1 = *(const LAS f32x4*)(wsl + 128 + 32 * ks + 8 * fq + 4);
        float a[8], b[8];
#pragma unroll
        for (int j = 0; j < 8; ++j) { const float kv = bf2f(raw[j]); a[j] = kv * (j < 4 ? wf0[j & 3] : wf1[j & 3]); b[j] = kv * (j < 4 ? wb0[j & 3] : wb1[j & 3]); unf += a[j]; unb += b[j]; }
        u32x4 pa, pb; pa.x = pk2(a[0], a[1]); pa.y = pk2(a[2], a[3]); pa.z = pk2(a[4], a[5]); pa.w = pk2(a[6], a[7]);
        pb.x = pk2(b[0], b[1]); pb.y = pk2(b[2], b[3]); pb.z = pk2(b[4], b[5]); pb.w = pk2(b[6], b[7]);
        yf[ks] = __builtin_bit_cast(bf16x8, pa); yb[ks] = __builtin_bit_cast(bf16x8, pb); }
    float* uf = (float*)(F.ws + WS_UT) + ((size_t)((0 * NCHUNK + posf) * 8 + h) * 128) * 128;
    float* ub = (float*)(F.ws + WS_UT) + ((size_t)((1 * NCHUNK + posb) * 8 + h) * 128) * 128;
#pragma unroll
    for (int et = 0; et < 8; ++et) {
        const bf16* vrow = (const bf16*)(F.ws + WS_MVT) + (size_t)(h * 128 + 16 * et + fr) * MTOK + tok0 + 8 * fq;
        f32x4 af = {0.f, 0.f, 0.f, 0.f}, ab = {0.f, 0.f, 0.f, 0.f};
#pragma unroll
        for (int ks = 0; ks < 4; ++ks) { const bf16x8 xf = *(const bf16x8*)(vrow + 32 * ks); af = mfma16(xf, yf[ks], af); ab = mfma16(xf, yb[ks], ab); }
#pragma unroll
        for (int r = 0; r < 4; ++r) { uf[(size_t)(16 * et + 4 * fq + r) * 128 + 16 * w + fr] = af[r]; ub[(size_t)(16 * et + 4 * fq + r) * 128 + 16 * w + fr] = ab[r]; }
    }
    unf = qsum(unf); unb = qsum(unb);
    if (fq == 0) { ((float*)(F.ws + WS_UN))[((size_t)(0 * NCHUNK + posf) * 8 + h) * 128 + 16 * w + fr] = unf; ((float*)(F.ws + WS_UN))[((size_t)(1 * NCHUNK + posb) * 8 + h) * 128 + 16 * w + fr] = unb; }
    if (w == 0 && lane == 0) { float* bg = (float*)(F.ws + WS_BLGM);
        bg[((0 * NCHUNK + posf) * 8 + h) * 2] = g.bl_f; bg[((0 * NCHUNK + posf) * 8 + h) * 2 + 1] = gmf; bg[((1 * NCHUNK + posb) * 8 + h) * 2] = g.bl_b; bg[((1 * NCHUNK + posb) * 8 + h) * 2 + 1] = gmb; }
    LDS_FENCE();
}
__device__ __forceinline__ void scan_phase(Frame& F) {
    const float* UT = (const float*)(F.ws + WS_UT); const float* UN = (const float*)(F.ws + WS_UN); const float* BG = (const float*)(F.ws + WS_BLGM);
    bf16* CT = (bf16*)(F.ws + WS_CT); float* CN = (float*)(F.ws + WS_CN); float* CM = (float*)(F.ws + WS_CM);
    const int NT = F.G * NTHR;
    for (int gid = blockIdx.x * NTHR + F.tid; gid < 65536 + 512; gid += NT) {
        if (gid < 65536) {
            const int d4 = gid & 31, e = (gid >> 5) & 127, h = (gid >> 12) & 7, dir = gid >> 15;
            const size_t base = ((size_t)(dir * NCHUNK * 8 + h) * 128 + e) * 128 + d4 * 4, pstride = (size_t)8 * 128 * 128;
            f32x4 C = {0.f, 0.f, 0.f, 0.f}; float m = 0.f;
#pragma unroll 6
            for (int pos = 0; pos < NCHUNK; ++pos) {
                u32x2 o; o.x = pk2(C[0], C[1]); o.y = pk2(C[2], C[3]); *(u32x2*)(CT + base + pos * pstride) = o;
                if (e == 0 && d4 == 0) CM[(dir * NCHUNK + pos) * 8 + h] = m;
                const float bl = BG[((dir * NCHUNK + pos) * 8 + h) * 2], gm = BG[((dir * NCHUNK + pos) * 8 + h) * 2 + 1];
                const float mn = fmaxf(bl + m, gm), dec = __expf(bl + m - mn), sc = __expf(gm - mn);
                const f32x4 u = *(const f32x4*)(UT + base + pos * pstride);
                C = C * dec + u * sc; m = mn;
            }
        } else {
            const int k = gid - 65536, d4 = k & 31, h = (k >> 5) & 7, dir = k >> 8;
            const size_t base = ((size_t)(dir * NCHUNK * 8 + h)) * 128 + d4 * 4, pstride = (size_t)8 * 128;
            f32x4 C = {0.f, 0.f, 0.f, 0.f}; float m = 0.f;
            for (int pos = 0; pos < NCHUNK; ++pos) {
                *(f32x4*)(CN + base + pos * pstride) = C;
                const float bl = BG[((dir * NCHUNK + pos) * 8 + h) * 2], gm = BG[((dir * NCHUNK + pos) * 8 + h) * 2 + 1];
                const float mn = fmaxf(bl + m, gm), dec = __expf(bl + m - mn), sc = __expf(gm - mn);
                const f32x4 u = *(const f32x4*)(UN + base + pos * pstride);
                C = C * dec + u * sc; m = mn;
            }
        }
    }
}
constexpr int MO_K = 0, MO_V = 32768, MO_CF = 65536, MO_CB = 98304, MO_COL = 131072;
__device__ __forceinline__ void mlstm_out_unit(Frame& F, int l, int c, int h) {
    int tid_ = F.tid; asm volatile("" : "+v"(tid_));
    const int tid = tid_, lane = tid & 63, w = __builtin_amdgcn_readfirstlane(tid >> 6), fr = lane & 15, fq = lane >> 4, tok0 = c * 128, t = 16 * w + fr;
    const int posf = (c + 2) % NCHUNK, posb = 65 - c;
    LAS unsigned char* lds = F.lds;
    const bf16* ctf = (const bf16*)(F.ws + WS_CT) + ((size_t)((0 * NCHUNK + posf) * 8 + h) * 128) * 128;
    const bf16* ctb = (const bf16*)(F.ws + WS_CT) + ((size_t)((1 * NCHUNK + posb) * 8 + h) * 128) * 128;
    bf16x8 gk[4], gv[4], gcf[4], gcb[4];
#pragma unroll
    for (int i = 0; i < 4; ++i) { const int idx = tid + 512 * i, row = idx >> 4, ch = idx & 15;
        gk[i] = *(const bf16x8*)((const bf16*)(F.ws + WS_KC) + (size_t)(tok0 + row) * 1024 + h * 128 + 8 * ch);
        gv[i] = *(const bf16x8*)((const bf16*)(F.ws + WS_MVT) + (size_t)(h * 128 + row) * MTOK + tok0 + 8 * ch);
        gcf[i] = *(const bf16x8*)(ctf + row * 128 + 8 * ch); gcb[i] = *(const bf16x8*)(ctb + row * 128 + 8 * ch); }
    __builtin_amdgcn_sched_barrier(0);
    const bf16* qrow = (const bf16*)(F.ws + WS_QC) + (size_t)(tok0 + t) * 1024 + h * 128 + 8 * fq;
    bf16x8 qf[4];
#pragma unroll
    for (int ks = 0; ks < 4; ++ks) qf[ks] = *(const bf16x8*)(qrow + 32 * ks);
    MG g; mlstm_gates((const float*)(F.ws + WS_GATES) + (size_t)tok0 * 32 + h, lane, g);
    const float mf = ((const float*)(F.ws + WS_CM))[(0 * NCHUNK + posf) * 8 + h], mb = ((const float*)(F.ws + WS_CM))[(1 * NCHUNK + posb) * 8 + h];
    float cf[2], cb[2];
#pragma unroll
    for (int x = 0; x < 2; ++x) { cf[x] = g.i_f[x] - g.b_f[x]; cb[x] = g.i_b[x] - g.b_b[x]; }
    float pm[2], sm[2];
    { const float p0 = scan_up_max(cf[0], lane), tt = __shfl(p0, 63), p1 = fmaxf(scan_up_max(cf[1], lane), tt); pm[0] = p0; pm[1] = p1;
      const float q1 = scan_down_max(cb[1], lane), uu = __shfl(q1, 0), q0 = fmaxf(scan_down_max(cb[0], lane), uu); sm[0] = q0; sm[1] = q1; }
    LAS float* wsl = (LAS float*)(lds + MO_COL + 1024 * w);
    wsl[lane] = cf[0]; wsl[64 + lane] = cf[1]; wsl[128 + lane] = cb[0]; wsl[192 + lane] = cb[1];
    const int xh = w >> 2, sl = 16 * (w & 3) + fr;
    const float Mf = fmaxf(__shfl(xh ? pm[1] : pm[0], sl), mf), Mb = fmaxf(__shfl(xh ? sm[1] : sm[0], sl), mb);
    const float bft = __shfl(xh ? g.b_f[1] : g.b_f[0], sl), bbt = __shfl(xh ? g.b_b[1] : g.b_b[0], sl);
    const float rowf = -Mf, a_f = __expf(mf - Mf), fl_f = __expf(-(bft + Mf)), rowb = -Mb, a_b = __expf(mb - Mb), fl_b = __expf(-(bbt + Mb));
    __builtin_amdgcn_sched_barrier(0);
#pragma unroll
    for (int i = 0; i < 4; ++i) { const int idx = tid + 512 * i, row = idx >> 4, ch = idx & 15; const int o = row * 256 + ((ch ^ (row & 15)) << 4);
        *(LAS bf16x8*)(lds + MO_K + o) = gk[i]; *(LAS bf16x8*)(lds + MO_V + o) = gv[i]; *(LAS bf16x8*)(lds + MO_CF + o) = gcf[i]; *(LAS bf16x8*)(lds + MO_CB + o) = gcb[i]; }
    asm volatile("s_waitcnt lgkmcnt(0)" ::: "memory"); __syncthreads();
    const int rbase = fr * 256;
    bf16x8 pf[4], pb[4]; float dsf = 0.f, dsb = 0.f;
#pragma unroll
    for (int kb = 0; kb < 4; ++kb) {
        float vf[8], vb[8];
#pragma unroll
        for (int hh = 0; hh < 2; ++hh) { const int st = 2 * kb + hh;
            f32x4 S = {0.f, 0.f, 0.f, 0.f};
#pragma unroll
            for (int ks = 0; ks < 4; ++ks) S = mfma16(*(const LAS bf16x8*)(lds + MO_K + st * 4096 + rbase + (((4 * ks + fq) ^ fr) << 4)), qf[ks], S);
            const f32x4 c4f = *(const LAS f32x4*)(wsl + 16 * st + 4 * fq), c4b = *(const LAS f32x4*)(wsl + 128 + 16 * st + 4 * fq);
#pragma unroll
            for (int r = 0; r < 4; ++r) { const int s = 16 * st + 4 * fq + r;
                const float ef = (s <= t) ? __expf(rowf + c4f[r]) : 0.f, eb = (s >= t) ? __expf(rowb + c4b[r]) : 0.f;
                const float p1 = S[r] * ef, p2 = S[r] * eb; vf[4 * hh + r] = p1; vb[4 * hh + r] = p2; dsf += p1; dsb += p2; } }
        u32x4 a, b; a.x = pk2(vf[0], vf[1]); a.y = pk2(vf[2], vf[3]); a.z = pk2(vf[4], vf[5]); a.w = pk2(vf[6], vf[7]);
        b.x = pk2(vb[0], vb[1]); b.y = pk2(vb[2], vb[3]); b.z = pk2(vb[4], vb[5]); b.w = pk2(vb[6], vb[7]);
        pf[kb] = __builtin_bit_cast(bf16x8, a); pb[kb] = __builtin_bit_cast(bf16x8, b);
        __builtin_amdgcn_sched_barrier(0);
    }
    dsf = qsum(dsf); dsb = qsum(dsb);
    const float* nf = (const float*)(F.ws + WS_CN) + ((size_t)(0 * NCHUNK + posf) * 8 + h) * 128; const float* nb = (const float*)(F.ws + WS_CN) + ((size_t)(1 * NCHUNK + posb) * 8 + h) * 128;
    float qnf = 0.f, qnb = 0.f;
#pragma unroll
    for (int ks = 0; ks < 4; ++ks) { const f32x4 n0 = *(const f32x4*)(nf + 32 * ks + 8 * fq), n1 = *(const f32x4*)(nf + 32 * ks + 8 * fq + 4), m0 = *(const f32x4*)(nb + 32 * ks + 8 * fq), m1 = *(const f32x4*)(nb + 32 * ks + 8 * fq + 4);
#pragma unroll
        for (int j = 0; j < 8; ++j) { const float qv = bf2f(qf[ks][j]); qnf += qv * (j < 4 ? n0[j & 3] : n1[j & 3]); qnb += qv * (j < 4 ? m0[j & 3] : m1[j & 3]); } }
    qnf = qsum(qnf); qnb = qsum(qnb);
    const float inv_f = 1.0f / fmaxf(fabsf(a_f * qnf + dsf), fl_f), inv_b = 1.0f / fmaxf(fabsf(a_b * qnb + dsb), fl_b);
    f32x4 hs[8]; float ss = 0.f;
#pragma unroll
    for (int et = 0; et < 8; ++et) {
        f32x4 af = {0.f, 0.f, 0.f, 0.f}, ab = {0.f, 0.f, 0.f, 0.f};
#pragma unroll
        for (int ks = 0; ks < 4; ++ks) { const int o = et * 4096 + rbase + (((4 * ks + fq) ^ fr) << 4);
            af = mfma16(*(const LAS bf16x8*)(lds + MO_CF + o), qf[ks], af); ab = mfma16(*(const LAS bf16x8*)(lds + MO_CB + o), qf[ks], ab); }
        af = af * a_f; ab = ab * a_b;
#pragma unroll
        for (int kb = 0; kb < 4; ++kb) {
            const int o = MO_V + et * 4096 + rbase + 8 * (fq & 1);
            const bf16x8 xf = cat8(*(const LAS bf16x4*)(lds + o + (((4 * kb + (fq >> 1)) ^ fr) << 4)), *(const LAS bf16x4*)(lds + o + (((4 * kb + 2 + (fq >> 1)) ^ fr) << 4)));
            af = mfma16(xf, pf[kb], af); ab = mfma16(xf, pb[kb], ab); }
        hs[et] = af * inv_f + ab * inv_b;
        ss += (hs[et][0] * hs[et][0] + hs[et][1] * hs[et][1]) + (hs[et][2] * hs[et][2] + hs[et][3] * hs[et][3]);
        __builtin_amdgcn_sched_barrier(0);
    }
    ss = qsum(ss);
    const float rstd = rsqrtf(ss * (1.0f / 128.0f) + EPS);
    const float* ng = F.in[I_MNG] + (size_t)l * 1024 + h * 128;
    const bf16* orow = (const bf16*)(F.ws + WS_P) + (size_t)(tok0 + t) * DINP + PC_MO + h * 128;
    bf16* crow = (bf16*)(F.ws + WS_CAT) + (size_t)(tok0 + t) * D + 512 + h * 128;
#pragma unroll
    for (int et = 0; et < 8; ++et) { const int e = 16 * et + 4 * fq; const bf16x4 ov = *(const bf16x4*)(orow + e); const f32x4 gg = *(const f32x4*)(ng + e);
        float y[4];
#pragma unroll
        for (int r = 0; r < 4; ++r) y[r] = sigmoid_f(bf2f(ov[r])) * (hs[et][r] * rstd * gg[r]);
        *(bf16x4*)(crow + e) = pk4(y[0], y[1], y[2], y[3]); }
    asm volatile("s_waitcnt lgkmcnt(0)" ::: "memory"); __syncthreads();
}

__device__ __forceinline__ void sgu_unit(Frame& F, int l, int c, int g) {
    const int lane = F.lane, w = F.wave, fr = lane & 15, fq = lane >> 4, tok0 = c * 128, t = 16 * w + fr;
    const bf16* wrow = (const bf16*)(F.ws + WS_SGW) + ((size_t)(l * 4 + g) * 128 + t) * 128 + 8 * fq;
    bf16x8 yf[4];
#pragma unroll
    for (int ks = 0; ks < 4; ++ks) yf[ks] = *(const bf16x8*)(wrow + 32 * ks);
    const float bs = F.in[I_SGB][(size_t)(l * 4 + g) * 128 + t];
    const bf16* urow = (const bf16*)(F.ws + WS_P) + (size_t)(tok0 + t) * DINP + PC_U + g * 128;
    bf16* crow = (bf16*)(F.ws + WS_CAT) + (size_t)(tok0 + t) * D + g * 128;
#pragma unroll
    for (int ct = 0; ct < 8; ++ct) {
        const bf16* vrow = (const bf16*)(F.ws + WS_VNT) + (size_t)(g * 128 + 16 * ct + fr) * MTOK + tok0 + 8 * fq;
        f32x4 a = {0.f, 0.f, 0.f, 0.f};
#pragma unroll
        for (int ks = 0; ks < 4; ++ks) a = mfma16(*(const bf16x8*)(vrow + 32 * ks), yf[ks], a);
        const int cc = 16 * ct + 4 * fq; const bf16x4 uv = *(const bf16x4*)(urow + cc);
        float y[4];
#pragma unroll
        for (int r = 0; r < 4; ++r) y[r] = gelu_tanh(bf2f(uv[r])) * (a[r] + bs);
        *(bf16x4*)(crow + cc) = pk4(y[0], y[1], y[2], y[3]);
    }
}

constexpr int NA_KL = 0, NA_KC = 73728, NA_VL = 0, NA_VC = 66560, NA_MS = 110592;
template <bool LOCAL> __device__ __forceinline__ void na_unit(Frame& F, const float* rpb  , int r, int h) {
    const int tid = F.tid, lane = F.lane, wave = F.wave, fr = lane & 15, fq = lane >> 4, cb = wave & 3, part = wave >> 2;
    const bf16* P = (const bf16*)(F.ws + WS_P); const bf16* VT = (const bf16*)(F.ws + WS_NAVT);
    LAS unsigned char* lds = F.lds;
    int rs = r - 4; rs = rs < 0 ? 0 : (rs > 120 ? 120 : rs);
    {   bf16x8 kl[8], kc[4];
        if (LOCAL) {
#pragma unroll
            for (int i = 0; i < 8; ++i) { const int idx = tid + 512 * i, row = idx >> 3, ch = idx & 7; const int tok = (rs + (row >> 6)) * 64 + (row & 63);
                kl[i] = *(const bf16x8*)(P + (size_t)tok * DINP + PC_NK + h * 64 + 8 * ch); } }
#pragma unroll
        for (int i = 0; i < 4; ++i) { const int idx = tid + 512 * i, row = idx >> 3, ch = idx & 7;
            kc[i] = *(const bf16x8*)(P + (size_t)(SEQ + row) * DINP + PC_NK + h * 64 + 8 * ch); }
        if (LOCAL) {
#pragma unroll
            for (int i = 0; i < 8; ++i) { const int idx = tid + 512 * i, row = idx >> 3, ch = idx & 7; *(LAS bf16x8*)(lds + NA_KL + row * 144 + 16 * ch) = kl[i]; } }
#pragma unroll
        for (int i = 0; i < 4; ++i) { const int idx = tid + 512 * i, row = idx >> 3, ch = idx & 7; *(LAS bf16x8*)(lds + NA_KC + row * 144 + 16 * ch) = kc[i]; }
    }
    bf16x8 vl[8], vc[4];
    if (LOCAL) {
#pragma unroll
        for (int i = 0; i < 8; ++i) { const int idx = tid + 512 * i, row = idx >> 6, ch = idx & 63;
            vl[i] = *(const bf16x8*)(VT + (size_t)(h * 64 + row) * MTOK + (rs + (ch >> 3)) * 64 + 8 * (ch & 7)); } }
#pragma unroll
    for (int i = 0; i < 4; ++i) { const int idx = tid + 512 * i, row = idx >> 5, ch = idx & 31;
        vc[i] = *(const bf16x8*)(VT + (size_t)(h * 64 + row) * MTOK + SEQ + 8 * ch); }
    const int tokq = (LOCAL ? r * 64 : SEQ + r * 64) + 16 * cb + fr;
    const bf16* qrow = P + (size_t)tokq * DINP + PC_NQ + h * 64 + 8 * fq;
    const bf16x8 qf0 = *(const bf16x8*)qrow, qf1 = *(const bf16x8*)(qrow + 32);
    int kc0 = 16 * cb - 8; kc0 = kc0 < 0 ? 0 : (kc0 > 32 ? 32 : kc0);
    const int qc = 16 * cb + fr; int cs = qc - 8; cs = cs < 0 ? 0 : (cs > 48 ? 48 : cs);
    const bool loc = LOCAL && part == 0;
    constexpr int NT = LOCAL ? 16 : 8;
    asm volatile("s_waitcnt lgkmcnt(0)" ::: "memory"); __syncthreads();
    f32x4 S[NT]; float mx = -1e30f;
    const float* rpbh = rpb + (h * 15 + (rs - r + 7)) * 31 + (kc0 + 4 * fq - qc + 15);
#pragma unroll
    for (int kt = 0; kt < NT; ++kt) {
        const int krow = loc ? (kt >> 1) * 64 + kc0 + 16 * (kt & 1) + fr : (LOCAL ? 16 * kt : 128 * part + 16 * kt) + fr;
        const LAS unsigned char* kp = lds + (loc ? NA_KL : NA_KC) + krow * 144 + 16 * fq;
        f32x4 a = {0.f, 0.f, 0.f, 0.f};
        a = mfma16(*(const LAS bf16x8*)kp, qf0, a); a = mfma16(*(const LAS bf16x8*)(kp + 64), qf1, a);
#pragma unroll
        for (int rr = 0; rr < 4; ++rr) { float v = a[rr] * 0.125f;
            if (loc) { const int kc = kc0 + 4 * fq + 16 * (kt & 1) + rr; const bool valid = kc >= cs && kc < cs + 16;
                const float bias = valid ? rpbh[31 * (kt >> 1) + 16 * (kt & 1) + rr] : 0.f; v = valid ? v + bias : -1e30f; }
            a[rr] = v; mx = fmaxf(mx, v); }
        S[kt] = a;
    }
    mx = qmax(mx);
    float sum = 0.f; bf16x8 pfr[NT / 2];
#pragma unroll
    for (int kb = 0; kb < NT / 2; ++kb) { f32x4 a0 = S[2 * kb], a1 = S[2 * kb + 1];
#pragma unroll
        for (int rr = 0; rr < 4; ++rr) { a0[rr] = __expf(a0[rr] - mx); a1[rr] = __expf(a1[rr] - mx); sum += a0[rr] + a1[rr]; }
        u32x4 pp; pp.x = pk2(a0[0], a0[1]); pp.y = pk2(a0[2], a0[3]); pp.z = pk2(a1[0], a1[1]); pp.w = pk2(a1[2], a1[3]);
        pfr[kb] = __builtin_bit_cast(bf16x8, pp); }
    sum = qsum(sum);
    __syncthreads();
    if (LOCAL) {
#pragma unroll
        for (int i = 0; i < 8; ++i) { const int idx = tid + 512 * i, row = idx >> 6, ch = idx & 63; *(LAS bf16x8*)(lds + NA_VL + row * 1040 + 16 * ch) = vl[i]; } }
#pragma unroll
    for (int i = 0; i < 4; ++i) { const int idx = tid + 512 * i, row = idx >> 5, ch = idx & 31; *(LAS bf16x8*)(lds + NA_VC + row * 528 + 16 * ch) = vc[i]; }
    asm volatile("s_waitcnt lgkmcnt(0)" ::: "memory"); __syncthreads();
    f32x4 O[4];
#pragma unroll
    for (int dt = 0; dt < 4; ++dt) O[dt] = (f32x4){0.f, 0.f, 0.f, 0.f};
#pragma unroll
    for (int kb = 0; kb < NT / 2; ++kb) {
#pragma unroll
        for (int dt = 0; dt < 4; ++dt) {
            const LAS unsigned char* vp = loc ? lds + NA_VL + (16 * dt + fr) * 1040 + (kb * 64 + kc0 + 4 * fq) * 2
                                              : lds + NA_VC + (16 * dt + fr) * 528 + ((LOCAL ? 0 : 128 * part) + 32 * kb + 4 * fq) * 2;
            O[dt] = mfma16(cat8(*(const LAS bf16x4*)vp, *(const LAS bf16x4*)(vp + 32)), pfr[kb], O[dt]); }
    }
    LAS float* ms = (LAS float*)(lds + NA_MS) + cb * (18 * 64);
    if (part == 1) {
#pragma unroll
        for (int dt = 0; dt < 4; ++dt)
#pragma unroll
            for (int rr = 0; rr < 4; ++rr) ms[(dt * 4 + rr) * 64 + lane] = O[dt][rr];
        ms[16 * 64 + lane] = mx; ms[17 * 64 + lane] = sum;
    }
    asm volatile("s_waitcnt lgkmcnt(0)" ::: "memory"); __syncthreads();
    if (part == 0) {
        const float m2 = ms[16 * 64 + lane], l2 = ms[17 * 64 + lane];
        const float M = fmaxf(mx, m2), e1 = __expf(mx - M), e2 = __expf(m2 - M);
        const float inv = 1.0f / (sum * e1 + l2 * e2);
        bf16* crow = (bf16*)(F.ws + WS_CAT) + (size_t)tokq * D + 1536 + h * 64;
#pragma unroll
        for (int dt = 0; dt < 4; ++dt) { float y[4];
#pragma unroll
            for (int rr = 0; rr < 4; ++rr) y[rr] = (O[dt][rr] * e1 + ms[(dt * 4 + rr) * 64 + lane] * e2) * inv;
            *(bf16x4*)(crow + 16 * dt + 4 * fq) = pk4(y[0], y[1], y[2], y[3]); }
    }
    asm volatile("s_waitcnt lgkmcnt(0)" ::: "memory"); __syncthreads();
}

__global__ void __launch_bounds__(NTHR, 2) mk_fwd(Args args) {
    extern __shared__ __attribute__((aligned(16))) unsigned char lds[];
    Frame F;
    F.lds = (LAS unsigned char*)lds;
    frame_tid(F);
    F.G = gridDim.x; F.in = args.in; F.out = args.out; F.ws = args.ws;
    volatile LAS unsigned* MISC = (volatile LAS unsigned*)(F.lds + LDSCTL_OFF);
    for (int u = F.tid; u < (LDS_BYTES - LDSCTL_OFF) / 4; u += NTHR) MISC[u] = 0u;
    __syncthreads();
#if !MK_SPLIT
    (void)xcd_barrier_post((unsigned*)(args.ws + WS_CTL) + 4096, MISC + 8);
#endif
    const int lo = args.step_lo, hi = args.step_hi;
#define MODL ((const float*)(F.ws + WS_MOD) + (size_t)l * 2 * NMODV)
    int step = 0;
#define IN_STEP() (step >= lo && step < hi && (frame_site(F, args), true))
#if MK_SPLIT
#define END_STEP() do { ++step; } while (0)
#else
#define END_STEP() do { if (step >= lo && step + 1 < hi) { XcdBarrier b_; b_.bar = (unsigned*)(args.ws + WS_CTL) + 4096; b_.x = xb_xcc_id(); b_.st = MISC + 8; xcd_barrier(b_); } ++step; } while (0)
#endif

    if (IN_STEP()) for (int rp = 0; rp < REP_PRO; ++rp) p0_prologue(F);
    END_STEP();

    for (int l = 0; l < DEPTH; ++l) {
        for (int f = 0; f < 2; ++f) {
            if (IN_STEP()) for (int rp = 0; rp < REP_NORM; ++rp) norm_phase(F, F.in[I_NORMG] + (size_t)(l * 3 + 2 * f) * D, MODL, 6 * f, 6 * f + 1, MTOK, f == 0 ? (l == 0 ? 0 : 11) : 4);
            END_STEP();
            if (IN_STEP()) for (int rp = 0; rp < REP_G1; ++rp) {
                pg8::Gemm g{(const bf16*)(F.ws + WS_ABUF), (const bf16*)(F.ws + WS_W13T + (size_t)(l * 2 + f) * SZ_W13T), D, D};
                pg8::StaticOrder S; S.init(MTOK, 2 * DFF, F.G, (int)blockIdx.x);
                pg8::EpiSwiGLU E{(bf16*)(F.ws + WS_HB), DFF};
                pg8::gemm_phase<pg8::EpiSwiGLU, pg8::StaticOrder, true, true>(F.lds, g, S, E);
            }
            END_STEP();
            if (IN_STEP()) {
                {
                const float* gl = MODL + (6 * f + 2) * D; float* H = (float*)(F.ws + WS_H); bf16* HB = (bf16*)(F.ws + WS_HB);
                { pg8::Gemm g{HB, (const bf16*)(F.ws + WS_W2T + (size_t)(l * 2 + f) * SZ_W2T), DFF, DFF};
                  pg8::StaticOrder S; S.init(SEQ, D, F.G, (int)blockIdx.x);
                  pg8::EpiResid E{H, gl};
                  pg8::gemm_phase<pg8::EpiResid, pg8::StaticOrder, true, true>(F.lds, g, S, E); }
                { pg8::Gemm g{HB + (size_t)SEQ * DFF, (const bf16*)(F.ws + WS_W2T + (size_t)(l * 2 + f) * SZ_W2T), DFF, 512};
                  pg8::SplitKOrder S{8, DFF / 512, 512, F.G, (int)blockIdx.x};
                  pg8::EpiSlab E{(float*)(F.ws + WS_SLAB), gl + NMODV, 512};
                  pg8::gemm_phase<pg8::EpiSlab, pg8::SplitKOrder, true, true>(F.lds, g, S, E); }
                }
            }
            END_STEP();
            if (f == 0) {
                if (IN_STEP()) for (int rp = 0; rp < REP_NORM; ++rp) norm_phase(F, F.in[I_NORMG] + (size_t)(l * 3 + 1) * D, MODL, 3, 4, MTOK, 11);
                END_STEP();
                if (IN_STEP()) for (int rp = 0; rp < REP_G3; ++rp) {
                    pg8::Gemm g{(const bf16*)(F.ws + WS_ABUF), (const bf16*)(F.ws + WS_WINT + (size_t)l * SZ_WINT), D, D};
                    pg8::StaticOrder S; S.init(MTOK, DINP, F.G, (int)blockIdx.x);
                    pg8::EpiWin E{(bf16*)(F.ws + WS_P), (float*)(F.ws + WS_GATES), F.in[I_GATEB] + (size_t)l * 32};
                    pg8::gemm_phase<pg8::EpiWin, pg8::StaticOrder, true, true>(F.lds, g, S, E);
                }
                END_STEP();
                if (IN_STEP()) for (int rp = 0; rp < REP_PREP; ++rp) prep_phase(F, l);
                END_STEP();
                if (IN_STEP()) for (int rp = 0; rp < REP_LOC; ++rp) {
                    LAS float* wsl = (LAS float*)(F.lds + F.wave * 16384);
                    for (int u = blockIdx.x; u < NCHUNK * 8; u += F.G) mlstm_local_unit(F, u >> 3, u & 7, wsl);
                    for (int v = ((int)blockIdx.x + F.G - (NCHUNK * 8) % F.G) % F.G; v < NCHUNK * 4; v += F.G) sgu_unit(F, l, v >> 2, v & 3);
                }
                END_STEP();
                if (IN_STEP()) for (int rp = 0; rp < REP_SCAN; ++rp) scan_phase(F);
                END_STEP();
                if (IN_STEP()) for (int rp = 0; rp < REP_OUT; ++rp) {
                    const float* rpb = F.in[I_RPB] + (size_t)l * 8 * 15 * 31;
                    LAS float* wsl = (LAS float*)(F.lds + F.wave * 16384);
                    for (int rq = 0; rq < REP_MO; ++rq)
                    for (int u = blockIdx.x; u < NCHUNK * 8; u += F.G) mlstm_out_unit(F, l, u >> 3, u & 7);
                    __syncthreads();
                    for (int rq = 0; rq < REP_NA; ++rq)
                    for (int v = ((int)blockIdx.x + F.G - (NCHUNK * 8) % F.G) % F.G; v < 1024; v += F.G) na_unit<true>(F, rpb, v >> 3, v & 7);
                    for (int v = blockIdx.x; v < 32; v += F.G) na_unit<false>(F, rpb, v >> 3, v & 7);
                }
                END_STEP();
                if (IN_STEP()) {
                    const float* gl = MODL + 5 * D; float* H = (float*)(F.ws + WS_H); bf16* CAT = (bf16*)(F.ws + WS_CAT);
                    { pg8::Gemm g{CAT, (const bf16*)(F.ws + WS_WOUTT + (size_t)l * SZ_WOUTT), D, D};
                      pg8::StaticOrder S; S.init(SEQ, D, F.G, (int)blockIdx.x);
                      pg8::EpiResid E{H, gl};
                      pg8::gemm_phase<pg8::EpiResid, pg8::StaticOrder, true, true>(F.lds, g, S, E); }
                    { pg8::Gemm g{CAT + (size_t)SEQ * D, (const bf16*)(F.ws + WS_WOUTT + (size_t)l * SZ_WOUTT), D, 512};
                      pg8::SplitKOrder S{8, D / 512, 512, F.G, (int)blockIdx.x};
                      pg8::EpiSlab E{(float*)(F.ws + WS_SLAB), gl + NMODV, 512};
                      pg8::gemm_phase<pg8::EpiSlab, pg8::SplitKOrder, true, true>(F.lds, g, S, E); }
                }
                END_STEP();
            }
        }
    }
    if (IN_STEP()) final_norm_phase(F);
#undef MODL
#undef IN_STEP
#undef END_STEP
}
constexpr int N_STEPS = 1 + DEPTH * 13 + 1;

extern "C" void kernel_launch(void* const* d_in, const int* in_sizes, int n_in, void* d_out, int out_size, void* d_ws, size_t ws_size, hipStream_t stream) {
    static int grid = 0;
    if (grid == 0) {
        if (n_in != 22 || out_size != SEQ * D || ws_size < WS_END) { fprintf(stderr, "kernel_launch: unexpected shapes (n_in %d, out %d, ws %zu < %zu)\n", n_in, out_size, ws_size, (size_t)WS_END); grid = -1; return; }
        int dev = 0, cus = 0, per_cu = 0;
        if (hipGetDevice(&dev) != hipSuccess || hipDeviceGetAttribute(&cus, hipDeviceAttributeMultiprocessorCount, dev) != hipSuccess) { grid = -1; return; }
        if (hipFuncSetAttribute((const void*)mk_fwd, hipFuncAttributeMaxDynamicSharedMemorySize, LDS_BYTES) != hipSuccess) { fprintf(stderr, "kernel_launch: hipFuncSetAttribute failed\n"); grid = -1; return; }
        if (hipOccupancyMaxActiveBlocksPerMultiprocessor(&per_cu, (const void*)mk_fwd, NTHR, LDS_BYTES) != hipSuccess || per_cu < 1) fprintf(stderr, "kernel_launch: occupancy query says %d\n", per_cu);
        (void)hipGetLastError();
        grid = cus;
    }
    if (grid < 0) return;
    (void)hipMemsetAsync((char*)d_ws + WS_CTL, 0, CTL_ZERO_BYTES, stream);
    Args a{};
    for (int i = 0; i < 22; ++i) a.in[i] = (const float*)d_in[i];
    a.out = (float*)d_out; a.ws = (unsigned char*)d_ws;
#if MK_SPLIT
    for (int s = 0; s < N_STEPS; ++s) { a.step_lo = s; a.step_hi = s + 1; hipLaunchKernelGGL(mk_fwd, dim3(grid), dim3(NTHR), LDS_BYTES, stream, a); }
#else
    a.step_lo = 0; a.step_hi = N_STEPS;
    hipLaunchKernelGGL(mk_fwd, dim3(grid), dim3(NTHR), LDS_BYTES, stream, a);
#endif
    const hipError_t le = hipPeekAtLastError();
    if (le != hipSuccess) fprintf(stderr, "kernel_launch: launch failed: %s\n", hipGetErrorName(le));
}
```

```cpp
#include <hip/hip_runtime.h>
#include <cstdio>
#include <cstdint>

#ifndef MK_SPLIT
#define MK_SPLIT 0
#endif

#ifndef REP_PRO
#define REP_PRO 1
#endif
#ifndef REP_NORM
#define REP_NORM 1
#endif
#ifndef REP_G1
#define REP_G1 1
#endif
#ifndef REP_MO
#define REP_MO 1
#endif
#ifndef REP_NA
#define REP_NA 1
#endif
#ifndef REP_BAR
#define REP_BAR 1
#endif
#ifndef REP_CVT
#define REP_CVT 1
#endif
#ifndef REP_G3
#define REP_G3 1
#endif
#ifndef REP_PREP
#define REP_PREP 1
#endif
#ifndef REP_LOC
#define REP_LOC 1
#endif
#ifndef REP_SCAN
#define REP_SCAN 1
#endif
#ifndef REP_OUT
#define REP_OUT 1
#endif
#define GAS __attribute__((address_space(1)))
#define LAS __attribute__((address_space(3)))

namespace pg8 {
#define PG8_LAS __attribute__((address_space(3)))
typedef unsigned short bf16_t;
typedef short bf16x8 __attribute__((ext_vector_type(8)));
typedef float f32x4 __attribute__((ext_vector_type(4)));
typedef unsigned u32x4 __attribute__((ext_vector_type(4)));
constexpr int BM = 256, BK = 64, HALF = 128, HTB = HALF * BK * 2  , STAGE_BYTES = 8 * HTB, NXCD = 8, WGM = 8;

__host__ __device__ __forceinline__ int lds_byte(int r, int c) { const int st = (r >> 4) * 2 + (c >> 5), rr = r & 15, cc = c & 31, ob = rr * 64 + cc * 2; return st * 1024 + (ob ^ (((ob >> 9) & 1) << 5)); }
__host__ __device__ __forceinline__ void stage_rc(int b, int& R, int& C) { const int st = b / 1024, sb = b % 1024, swz = sb ^ (((sb >> 9) & 1) << 5); R = (st >> 1) * 16 + swz / 64; C = (st & 1) * 32 + (swz % 64) / 2; }
__host__ __device__ __forceinline__ int perm32(int rho) { const int n = rho >> 4, i = rho & 15; return 8 * (i >> 2) + 4 * n + (i & 3); }

struct Unit { int pm, pn, koff; };
struct Gemm { const bf16_t* A; const bf16_t* Bt; int ld, K; };

struct StaticOrder {
    int nM, nN, nwg, G, c;
    __host__ __device__ void init(int M, int N, int G_, int c_) { nM = M / BM; nN = N / BM; nwg = nM * nN; G = G_; c = c_; }
    __host__ __device__ bool next(int i, Unit& u) const {
        const long L = (long)i * G + c; if (L >= nwg) return false;
        int wgid = (int)L; { const int q = nwg / NXCD, r = nwg % NXCD, xcd = wgid % NXCD, off = wgid / NXCD; wgid = (xcd < r ? xcd * (q + 1) : r * (q + 1) + (xcd - r) * q) + off; }
        const int nig = WGM * nN, gid = wgid / nig, fm = gid * WGM, gsz = (nM - fm) < WGM ? (nM - fm) : WGM;
        u.pm = fm + ((wgid % nig) % gsz); u.pn = (wgid % nig) / gsz; u.koff = 0; return true;
    }
    __device__ __forceinline__ void a_ready(const Unit&) const {}
    __device__ __forceinline__ void done(const Unit&) const {}
};
struct SplitKOrder {
    int nN, nK, kslice, G, c;
    __host__ __device__ bool next(int i, Unit& u) const {
        const long L = (long)i * G + c; if (L >= (long)nN * nK) return false;
        u.pm = 0; u.pn = (int)(L % nN); u.koff = (int)(L / nN) * kslice; return true;
    }
    __device__ __forceinline__ void a_ready(const Unit&) const {}
    __device__ __forceinline__ void done(const Unit&) const {}
};

__device__ __forceinline__ unsigned cvt_pk_bf16(float lo, float hi) { unsigned r; asm volatile("v_cvt_pk_bf16_f32 %0, %1, %2" : "=v"(r) : "v"(lo), "v"(hi)); return r; }
__device__ __forceinline__ float silu_f(float a) { return a * __builtin_amdgcn_rcpf(1.0f + __expf(-a)); }

struct EpiSwiGLU {
    static constexpr bool PERM = true, AFTER_DRAIN = false;
    bf16_t* O; int ldc;
    __device__ __forceinline__ void operator()(const f32x4 (&acc)[2][2][4][2], const Unit& u, int wr, int wc, int fr, int fq) const {
        const int row0 = u.pm * BM + wr * 64 + fr, col0 = u.pn * HALF + wc * 32 + 8 * fq;
#pragma unroll
        for (int ai = 0; ai < 2; ++ai)
#pragma unroll
            for (int m = 0; m < 4; ++m) { bf16_t* rowp = O + (size_t)(row0 + ai * HALF + m * 16) * ldc + col0;
                const f32x4 a0 = acc[ai][0][m][0], a1 = acc[ai][0][m][1], g0 = acc[ai][1][m][0], g1 = acc[ai][1][m][1];
                u32x4 w; w.x = cvt_pk_bf16(silu_f(a0[0]) * g0[0], silu_f(a0[1]) * g0[1]); w.y = cvt_pk_bf16(silu_f(a0[2]) * g0[2], silu_f(a0[3]) * g0[3]);
                w.z = cvt_pk_bf16(silu_f(a1[0]) * g1[0], silu_f(a1[1]) * g1[1]); w.w = cvt_pk_bf16(silu_f(a1[2]) * g1[2], silu_f(a1[3]) * g1[3]);
                *(u32x4*)rowp = w; }
    }
};
struct EpiResid {
    static constexpr bool PERM = false, AFTER_DRAIN = false;
    float* H; const float* gate;
    __device__ __forceinline__ void operator()(const f32x4 (&acc)[2][2][4][2], const Unit& u, int wr, int wc, int fr, int fq) const {
        const int row0 = u.pm * BM + wr * 64 + fr, col0 = u.pn * BM + wc * 32 + 4 * fq;
        f32x4 gv[2][2];
#pragma unroll
        for (int bj = 0; bj < 2; ++bj)
#pragma unroll
            for (int n = 0; n < 2; ++n) gv[bj][n] = *(const f32x4*)(gate + col0 + bj * HALF + n * 16);
#pragma unroll
        for (int ai = 0; ai < 2; ++ai)
#pragma unroll
            for (int m = 0; m < 4; ++m) { float* rowp = H + (size_t)(row0 + ai * HALF + m * 16) * 2048 + col0;
#pragma unroll
                for (int bj = 0; bj < 2; ++bj)
#pragma unroll
                    for (int n = 0; n < 2; ++n) { float* p = rowp + bj * HALF + n * 16; *(f32x4*)p = *(const f32x4*)p + gv[bj][n] * acc[ai][bj][m][n]; }
                asm volatile("" ::: "memory"); }
    }
};
struct EpiSlab {
    static constexpr bool PERM = false, AFTER_DRAIN = false;
    float* SLAB; const float* gate; int kslice;
    __device__ __forceinline__ void operator()(const f32x4 (&acc)[2][2][4][2], const Unit& u, int wr, int wc, int fr, int fq) const {
        const int row0 = wr * 64 + fr, col0 = u.pn * BM + wc * 32 + 4 * fq;
        float* base = SLAB + (size_t)(u.koff / kslice) * 256 * 2048;
        f32x4 gv[2][2];
#pragma unroll
        for (int bj = 0; bj < 2; ++bj)
#pragma unroll
            for (int n = 0; n < 2; ++n) gv[bj][n] = *(const f32x4*)(gate + col0 + bj * HALF + n * 16);
#pragma unroll
        for (int ai = 0; ai < 2; ++ai)
#pragma unroll
            for (int m = 0; m < 4; ++m) { float* rowp = base + (size_t)(row0 + ai * HALF + m * 16) * 2048 + col0;
#pragma unroll
                for (int bj = 0; bj < 2; ++bj)
#pragma unroll
                    for (int n = 0; n < 2; ++n) *(f32x4*)(rowp + bj * HALF + n * 16) = gv[bj][n] * acc[ai][bj][m][n]; }
    }
};
struct EpiWin {
    static constexpr bool PERM = true, AFTER_DRAIN = false;
    bf16_t* P; float* GATES; const float* gate_b;
    __device__ __forceinline__ void operator()(const f32x4 (&acc)[2][2][4][2], const Unit& u, int wr, int wc, int fr, int fq) const {
        const int row0 = u.pm * BM + wr * 64 + fr;
        if (u.pn < 26) {
            const int col0 = u.pn * BM + wc * 32 + 8 * fq;
#pragma unroll
            for (int ai = 0; ai < 2; ++ai)
#pragma unroll
                for (int m = 0; m < 4; ++m) { bf16_t* rowp = P + (size_t)(row0 + ai * HALF + m * 16) * 6912 + col0;
#pragma unroll
                    for (int bj = 0; bj < 2; ++bj) { const f32x4 v0 = acc[ai][bj][m][0], v1 = acc[ai][bj][m][1];
                        u32x4 w; w.x = cvt_pk_bf16(v0[0], v0[1]); w.y = cvt_pk_bf16(v0[2], v0[3]); w.z = cvt_pk_bf16(v1[0], v1[1]); w.w = cvt_pk_bf16(v1[2], v1[3]);
                        *(u32x4*)(rowp + bj * HALF) = w; } }
        } else if (wc == 0) {
            const f32x4 b0 = *(const f32x4*)(gate_b + 8 * fq), b1 = *(const f32x4*)(gate_b + 8 * fq + 4);
#pragma unroll
            for (int ai = 0; ai < 2; ++ai)
#pragma unroll
                for (int m = 0; m < 4; ++m) { float* rowp = GATES + (size_t)(row0 + ai * HALF + m * 16) * 32 + 8 * fq;
                    *(f32x4*)rowp = acc[ai][0][m][0] + b0; *(f32x4*)(rowp + 4) = acc[ai][0][m][1] + b1; }
        }
    }
};

template <class Epi, class Sched, bool ALIGN_EPI = false, bool SP2 = false>
__device__ __forceinline__ void gemm_phase(PG8_LAS unsigned char* lds, const Gemm g, const Sched& S, const Epi& E) {
    int tid_ = threadIdx.x; asm volatile("" : "+v"(tid_));
    const int tid = tid_, wid = __builtin_amdgcn_readfirstlane(tid >> 6), lane = tid & 63, wr = wid >> 2, wc = wid & 3, fr = lane & 15, fq = lane >> 4;
    const int ld = g.ld; int nt = g.K / BK; asm volatile("" : "+s"(nt));
    unsigned voffA[2], voffB[2];
#pragma unroll
    for (int i = 0; i < 2; ++i) { int R, C; stage_rc(tid * 16 + i * 8192, R, C); const int Rb = Epi::PERM ? ((R & ~31) + perm32(R & 31)) : R;
        voffA[i] = (unsigned)(R * ld + C) * 2u; voffB[i] = (unsigned)(Rb * ld + C) * 2u; }
    const size_t kstep = (size_t)(BK * 2);
    const size_t hstep = (size_t)HALF * ld * 2;
    const size_t tstep = 2 * hstep;
    const unsigned ldsw = (unsigned)wid * 1024u;
    const int aoff = lds_byte(wr * 64 + fr, fq * 8), boff = lds_byte(wc * 32 + fr, fq * 8);
#define PG8_SA(b, h) (((b) * 2 + (h)) * HTB)
#define PG8_SB(b, h) ((4 + (b) * 2 + (h)) * HTB)
#define PG8_STAGE(bufoff, gbase, voff) do { _Pragma("unroll") for (int _i = 0; _i < 2; ++_i) \
        __builtin_amdgcn_global_load_lds((const unsigned*)((const char*)(gbase) + (voff)[_i]), (PG8_LAS unsigned*)(lds + (bufoff) + ldsw + _i * 8192), 16, 0, 0); } while (0)
#define PG8_LDA(dst, b, h) do { _Pragma("unroll") for (int m = 0; m < 4; ++m) _Pragma("unroll") for (int k = 0; k < 2; ++k) dst[m][k] = *(const PG8_LAS bf16x8*)(lds + PG8_SA(b, h) + aoff + m * 2048 + k * 1024); } while (0)
#define PG8_LDB(dst, b, h) do { _Pragma("unroll") for (int n = 0; n < 2; ++n) _Pragma("unroll") for (int k = 0; k < 2; ++k) dst[n][k] = *(const PG8_LAS bf16x8*)(lds + PG8_SB(b, h) + boff + n * 2048 + k * 1024); } while (0)
#define PG8_MMA(ai, bj, At, Bt) do { __builtin_amdgcn_s_setprio(1); _Pragma("unroll") for (int m = 0; m < 4; ++m) _Pragma("unroll") for (int n = 0; n < 2; ++n) _Pragma("unroll") for (int k = 0; k < 2; ++k) \
        acc[ai][bj][m][n] = __builtin_amdgcn_mfma_f32_16x16x32_bf16(Bt[n][k], At[m][k], acc[ai][bj][m][n], 0, 0, 0); __builtin_amdgcn_s_setprio(0); } while (0)
#define PG8_WAIT_V(n) asm volatile("s_waitcnt vmcnt(" #n ")" ::: "memory")
#define PG8_WAIT_L(n) asm volatile("s_waitcnt lgkmcnt(" #n ")" ::: "memory")
#define PG8_BAR __builtin_amdgcn_s_barrier()
#define PG8_SCHED __builtin_amdgcn_sched_barrier(0)
    Unit cur, nxt; int ui = 0;
    if (!S.next(0, cur)) return;
    f32x4 acc[2][2][4][2];
#pragma unroll
    for (int a = 0; a < 2; ++a)
#pragma unroll
        for (int b = 0; b < 2; ++b)
#pragma unroll
            for (int m = 0; m < 4; ++m)
#pragma unroll
                for (int n = 0; n < 2; ++n) acc[a][b][m][n] = (f32x4){0.f, 0.f, 0.f, 0.f};
    bf16x8 At[4][2], B0[2][2], B1[2][2];
    const char* cA = (const char*)g.A + (size_t)cur.pm * tstep + (size_t)cur.koff * 2; const char* cB = (const char*)g.Bt + (size_t)cur.pn * tstep + (size_t)cur.koff * 2;
    S.a_ready(cur);
    if constexpr (SP2) {
        PG8_STAGE(PG8_SB(0, 0), cB, voffB); PG8_STAGE(PG8_SB(0, 1), cB + hstep, voffB); PG8_STAGE(PG8_SA(0, 0), cA, voffA); PG8_STAGE(PG8_SA(0, 1), cA + hstep, voffA);
        if (wr == 1) PG8_BAR;
        PG8_WAIT_V(2); PG8_BAR;
        PG8_STAGE(PG8_SB(1, 0), cB + kstep, voffB); PG8_STAGE(PG8_SA(1, 0), cA + kstep, voffA); PG8_STAGE(PG8_SB(1, 1), cB + hstep + kstep, voffB);
        PG8_WAIT_V(6); PG8_BAR;
    } else {
        PG8_STAGE(PG8_SB(0, 0), cB, voffB); PG8_STAGE(PG8_SA(0, 0), cA, voffA); PG8_STAGE(PG8_SB(0, 1), cB + hstep, voffB); PG8_STAGE(PG8_SA(0, 1), cA + hstep, voffA);
        if (wr == 1) PG8_BAR;
        PG8_WAIT_V(4); PG8_BAR;
        PG8_STAGE(PG8_SB(1, 0), cB + kstep, voffB); PG8_STAGE(PG8_SA(1, 0), cA + kstep, voffA); PG8_STAGE(PG8_SB(1, 1), cB + hstep + kstep, voffB);
        PG8_WAIT_V(6); PG8_BAR;
    }
    for (;;) {
        const bool has_next = S.next(ui + 1, nxt);
        const char* nA = has_next ? (const char*)g.A + (size_t)nxt.pm * tstep + (size_t)nxt.koff * 2 : cA; const char* nB = has_next ? (const char*)g.Bt + (size_t)nxt.pn * tstep + (size_t)nxt.koff * 2 : cB;
        for (int t = 0; t < nt; t += 2) {
            const bool last = (t == nt - 2);
            const char* a1 = cA + (size_t)(t + 1) * kstep;
            const char* a2 = last ? nA : cA + (size_t)(t + 2) * kstep; const char* b2 = last ? nB : cB + (size_t)(t + 2) * kstep;
            const char* a3 = a2 + kstep; const char* b3 = b2 + kstep;
            if (last && has_next) S.a_ready(nxt);
            if constexpr (SP2) {
            PG8_LDB(B0, 0, 0); PG8_LDB(B1, 0, 1); PG8_SCHED; PG8_LDA(At, 0, 0); PG8_STAGE(PG8_SA(1, 1), a1 + hstep, voffA);
            PG8_WAIT_V(8); PG8_WAIT_L(0); PG8_BAR; PG8_MMA(0, 0, At, B0); PG8_MMA(0, 1, At, B1); PG8_BAR; PG8_SCHED;
            PG8_LDA(At, 0, 1); PG8_STAGE(PG8_SB(0, 0), b2, voffB); PG8_STAGE(PG8_SB(0, 1), b2 + hstep, voffB); PG8_STAGE(PG8_SA(0, 0), a2, voffA);
            PG8_WAIT_V(8); PG8_WAIT_L(0); PG8_BAR; PG8_MMA(1, 0, At, B0); PG8_MMA(1, 1, At, B1); PG8_BAR; PG8_SCHED;
            PG8_LDB(B0, 1, 0); PG8_LDB(B1, 1, 1); PG8_SCHED; PG8_LDA(At, 1, 0); PG8_STAGE(PG8_SA(0, 1), a2 + hstep, voffA);
            PG8_WAIT_V(8); PG8_WAIT_L(0); PG8_BAR; PG8_MMA(0, 0, At, B0); PG8_MMA(0, 1, At, B1); PG8_BAR; PG8_SCHED;
            PG8_LDA(At, 1, 1); PG8_STAGE(PG8_SB(1, 0), b3, voffB); PG8_STAGE(PG8_SB(1, 1), b3 + hstep, voffB); PG8_STAGE(PG8_SA(1, 0), a3, voffA);
            PG8_WAIT_V(8); PG8_WAIT_L(0); PG8_BAR; PG8_MMA(1, 0, At, B0); PG8_MMA(1, 1, At, B1); PG8_BAR; PG8_SCHED;
            } else {
            PG8_LDB(B0, 0, 0); PG8_SCHED; PG8_LDA(At, 0, 0); PG8_STAGE(PG8_SA(1, 1), a1 + hstep, voffA);
            PG8_WAIT_L(8); PG8_BAR; PG8_WAIT_L(0); PG8_MMA(0, 0, At, B0); PG8_BAR; PG8_SCHED;
            PG8_LDB(B1, 0, 1); PG8_STAGE(PG8_SB(0, 0), b2, voffB);
            PG8_BAR; PG8_WAIT_L(0); PG8_MMA(0, 1, At, B1); PG8_BAR;
            PG8_LDA(At, 0, 1); PG8_STAGE(PG8_SA(0, 0), a2, voffA);
            PG8_BAR; PG8_WAIT_L(0); PG8_MMA(1, 0, At, B0); PG8_BAR; PG8_SCHED;
            PG8_STAGE(PG8_SB(0, 1), b2 + hstep, voffB);
            PG8_WAIT_V(6); PG8_BAR; PG8_MMA(1, 1, At, B1); PG8_BAR;
            PG8_LDB(B0, 1, 0); PG8_SCHED; PG8_LDA(At, 1, 0); PG8_STAGE(PG8_SA(0, 1), a2 + hstep, voffA);
            PG8_WAIT_L(8); PG8_BAR; PG8_WAIT_L(0); PG8_MMA(0, 0, At, B0); PG8_BAR; PG8_SCHED;
            PG8_LDB(B1, 1, 1); PG8_STAGE(PG8_SB(1, 0), b3, voffB);
            PG8_BAR; PG8_WAIT_L(0); PG8_MMA(0, 1, At, B1); PG8_BAR;
            PG8_LDA(At, 1, 1); PG8_STAGE(PG8_SA(1, 0), a3, voffA);
            PG8_BAR; PG8_WAIT_L(0); PG8_MMA(1, 0, At, B0); PG8_BAR; PG8_SCHED;
            PG8_STAGE(PG8_SB(1, 1), b3 + hstep, voffB);
            PG8_WAIT_V(6); PG8_BAR; PG8_MMA(1, 1, At, B1); PG8_BAR;
            }
        }
        if constexpr (ALIGN_EPI) { if (wr == 0) PG8_BAR; }
        if constexpr (!Epi::AFTER_DRAIN) { E(acc, cur, wr, wc, fr, fq); S.done(cur); }
        if (!has_next) break;
#pragma unroll
        for (int a = 0; a < 2; ++a)
#pragma unroll
            for (int b = 0; b < 2; ++b)
#pragma unroll
                for (int m = 0; m < 4; ++m)
#pragma unroll
                    for (int n = 0; n < 2; ++n) acc[a][b][m][n] = (f32x4){0.f, 0.f, 0.f, 0.f};
        cur = nxt; cA = nA; cB = nB; ++ui;
        if constexpr (ALIGN_EPI) { if (wr == 1) PG8_BAR; }
    }
    PG8_WAIT_V(0);
    if constexpr (!ALIGN_EPI) { if (wr == 0) PG8_BAR; }
    PG8_BAR;
#undef PG8_SA
#undef PG8_SB
#undef PG8_STAGE
#undef PG8_LDA
#undef PG8_LDB
#undef PG8_MMA
#undef PG8_WAIT_V
#undef PG8_WAIT_L
#undef PG8_BAR
#undef PG8_SCHED
}
}

constexpr int D = 2048, SEQ = 8192, CTXL = 256, MTOK = SEQ + CTXL, DEPTH = 4, DFF = 5632, NMODV = 9 * D;
constexpr int DIN = 6688, DINP = 6912;
constexpr int NCHUNK = 66;
constexpr float EPS = 1e-6f;
constexpr int NWAVES = 8, NTHR = 512;
constexpr int PC_U = 0, PC_V = 512, PC_MQ = 1024, PC_MK = 2048, PC_MV = 3072, PC_MO = 4096, PC_NQ = 5120, PC_NK = 5632, PC_NV = 6144;

constexpr size_t MiB = 1u << 20;
constexpr size_t WS_CTL = 0, CTL_ZERO_BYTES = 1 * MiB;
constexpr size_t WS_MOD = 1 * MiB;
constexpr size_t WS_ROPE = 2 * MiB;
constexpr size_t WS_SGW = 3 * MiB;
constexpr size_t SZ_W13T = (size_t)2 * DFF * D * 2, SZ_W2T = (size_t)D * DFF * 2, SZ_WINT = (size_t)DINP * D * 2, SZ_WOUTT = (size_t)D * D * 2;
constexpr size_t WS_W13T = 4 * MiB;
constexpr size_t WS_W2T = WS_W13T + 8 * SZ_W13T;
constexpr size_t WS_WINT = WS_W2T + 8 * SZ_W2T;
constexpr size_t WS_WOUTT = WS_WINT + 4 * SZ_WINT;
constexpr size_t WS_H = WS_WOUTT + 4 * SZ_WOUTT;
constexpr size_t WS_ABUF = WS_H + (size_t)MTOK * D * 4;
constexpr size_t WS_CAT = WS_ABUF + (size_t)MTOK * D * 2;
constexpr size_t WS_HB = WS_CAT + (size_t)MTOK * D * 2;
constexpr size_t WS_P = WS_HB + (size_t)MTOK * DFF * 2;
constexpr size_t WS_GATES = WS_P + (size_t)MTOK * DINP * 2;
constexpr size_t WS_QC = WS_GATES + (size_t)MTOK * 32 * 4;
constexpr size_t WS_KC = WS_QC + (size_t)MTOK * 1024 * 2;
constexpr size_t WS_KCT = WS_KC + (size_t)MTOK * 1024 * 2;
constexpr size_t WS_MVT = WS_KCT + (size_t)MTOK * 1024 * 2;
constexpr size_t WS_NAVT = WS_MVT + (size_t)MTOK * 1024 * 2;
constexpr size_t WS_VNT = WS_NAVT + (size_t)MTOK * 512 * 2;
constexpr size_t WS_UT = WS_VNT + (size_t)MTOK * 512 * 2;
constexpr size_t WS_UN = WS_UT + (size_t)2 * NCHUNK * 8 * 128 * 128 * 4;
constexpr size_t WS_BLGM = WS_UN + (size_t)2 * NCHUNK * 8 * 128 * 4;
constexpr size_t WS_CT = WS_BLGM + 1 * MiB;
constexpr size_t WS_CN = WS_CT + (size_t)2 * NCHUNK * 8 * 128 * 128 * 2;
constexpr size_t WS_CM = WS_CN + (size_t)2 * NCHUNK * 8 * 128 * 4;
constexpr size_t WS_SLAB = WS_CM + 1 * MiB;
constexpr size_t WS_END = WS_SLAB + (size_t)11 * 256 * 2048 * 4;

constexpr int RING_BYTES = 131072, LDSCTL_OFF = 143360, LDS_BYTES = 147456;

typedef unsigned short bf16;
typedef short bf16x8 __attribute__((ext_vector_type(8)));
typedef short bf16x4 __attribute__((ext_vector_type(4)));
typedef float f32x4 __attribute__((ext_vector_type(4)));
typedef float f32x2 __attribute__((ext_vector_type(2)));
typedef unsigned u32x4 __attribute__((ext_vector_type(4)));
typedef unsigned u32x2 __attribute__((ext_vector_type(2)));
typedef __bf16 bf16x2_t __attribute__((ext_vector_type(2)));
typedef GAS unsigned gu32;
#define RLX_AGENT __ATOMIC_RELAXED, __HIP_MEMORY_SCOPE_AGENT
#define LDS_FENCE() asm volatile("s_waitcnt lgkmcnt(0)" ::: "memory")

__device__ __forceinline__ float bf2f(short b) { return __uint_as_float(((unsigned)(unsigned short)b) << 16); }
__device__ __forceinline__ unsigned pk2(float lo, float hi) { f32x2 v = {lo, hi}; bf16x2_t b = __builtin_convertvector(v, bf16x2_t); return __builtin_bit_cast(unsigned, b); }
__device__ __forceinline__ short f2bf(float f) { return (short)(pk2(f, 0.f) & 0xffffu); }
__device__ __forceinline__ bf16x4 pk4(float a, float b, float c, float d) { u32x2 w; w.x = pk2(a, b); w.y = pk2(c, d); return __builtin_bit_cast(bf16x4, w); }
__device__ __forceinline__ bf16x8 cat8(bf16x4 lo, bf16x4 hi) { return __builtin_shufflevector(lo, hi, 0, 1, 2, 3, 4, 5, 6, 7); }
__device__ __forceinline__ f32x4 mfma16(bf16x8 a, bf16x8 b, f32x4 c) { return __builtin_amdgcn_mfma_f32_16x16x32_bf16(a, b, c, 0, 0, 0); }
__device__ __forceinline__ float wsum(float v) {
#pragma unroll
    for (int o = 1; o < 64; o <<= 1) v += __shfl_xor(v, o);
    return v; }
__device__ __forceinline__ float wmax(float v) {
#pragma unroll
    for (int o = 1; o < 64; o <<= 1) v = fmaxf(v, __shfl_xor(v, o));
    return v; }
__device__ __forceinline__ float qsum(float v) { v += __shfl_xor(v, 16); v += __shfl_xor(v, 32); return v; }
__device__ __forceinline__ float qmax(float v) { v = fmaxf(v, __shfl_xor(v, 16)); v = fmaxf(v, __shfl_xor(v, 32)); return v; }
__device__ __forceinline__ float scan_up_add(float v, int lane) {
#pragma unroll
    for (int o = 1; o < 64; o <<= 1) { const float t = __shfl_up(v, o); if (lane >= o) v += t; }
    return v; }
__device__ __forceinline__ float scan_down_add(float v, int lane) {
#pragma unroll
    for (int o = 1; o < 64; o <<= 1) { const float t = __shfl_down(v, o); if (lane + o < 64) v += t; }
    return v; }
__device__ __forceinline__ float scan_up_max(float v, int lane) {
#pragma unroll
    for (int o = 1; o < 64; o <<= 1) { const float t = __shfl_up(v, o); if (lane >= o) v = fmaxf(v, t); }
    return v; }
__device__ __forceinline__ float scan_down_max(float v, int lane) {
#pragma unroll
    for (int o = 1; o < 64; o <<= 1) { const float t = __shfl_down(v, o); if (lane + o < 64) v = fmaxf(v, t); }
    return v; }
__device__ __forceinline__ float sigmoid_f(float a) { return __builtin_amdgcn_rcpf(1.0f + __expf(-a)); }
__device__ __forceinline__ float silu_f(float a) { return a * sigmoid_f(a); }
__device__ __forceinline__ float gelu_tanh(float x) { const float u = 1.5957691216057308f * (x + 0.044715f * x * x * x); return x * sigmoid_f(u); }
__device__ __forceinline__ float logsig(float x) { return fminf(x, 0.f) - log1pf(__expf(-fabsf(x))); }

#define XB_TMO      128
#define XB_XCNT(j)  (256  + 64 * (j))
#define XB_XSUB(j)  (1280 + 64 * (j))
#define XB_XGEN(j)  (2304 + 64 * (j))
#define XB_TOP      3328
#define XB_TOPGEN   3392
#define XCD_BAR_WORDS 3456
#define XB_SPIN_CAP (1u << 20)
__device__ __forceinline__ unsigned xb_ld(unsigned* p)              { return __hip_atomic_load(p, __ATOMIC_RELAXED, __HIP_MEMORY_SCOPE_AGENT); }
__device__ __forceinline__ unsigned xb_add(unsigned* p, unsigned v) { return __hip_atomic_fetch_add(p, v, __ATOMIC_RELAXED, __HIP_MEMORY_SCOPE_AGENT); }
__device__ __forceinline__ unsigned xb_xcc_id() { return (unsigned)__builtin_amdgcn_s_getreg((3 << 11) | 20) & 0xFu; }
#define XB_SPIN(cond, bar) do { unsigned _sp = 0; while (cond) { __builtin_amdgcn_s_sleep(1); \
    if ((++_sp & 255u) == 0u) { if (xb_ld(&(bar)[XB_TMO])) break; if (_sp > XB_SPIN_CAP) { atomicAdd(&(bar)[XB_TMO], 1u); break; } } } } while (0)
struct XcdBarrier { unsigned* bar; unsigned x; volatile LAS unsigned* st; };
__device__ __forceinline__ XcdBarrier xcd_barrier_post(unsigned* bar, volatile LAS unsigned* st) {
    XcdBarrier b; b.bar = bar; b.x = xb_xcc_id(); b.st = st;
    if (threadIdx.x == 0) (void)xb_add(&bar[XB_XCNT(b.x)], 1u);
    return b;
}
__device__ __forceinline__ void xcd_barrier_complete(unsigned* bar, unsigned x, unsigned& nloc, unsigned& nx) {
    const unsigned G = gridDim.x * gridDim.y * gridDim.z;
    unsigned sum, cnt, mine, sp = 0u;
    for (;;) {
        sum = 0u; cnt = 0u; mine = 0u;
#pragma unroll
        for (unsigned j = 0; j < 16; ++j) { const unsigned c = xb_ld(&bar[XB_XCNT(j)]); sum += c; cnt += (c > 0u) ? 1u : 0u; mine = (j == x) ? c : mine; }
        if (sum == G) break;
        __builtin_amdgcn_s_sleep(1);
        if ((++sp & 255u) == 0u) { if (xb_ld(&bar[XB_TMO])) break; if (sp > XB_SPIN_CAP) { atomicAdd(&bar[XB_TMO], 1u); break; } }
    }
    nloc = mine > 0u ? mine : 1u; nx = cnt > 0u ? cnt : 1u;
}
__device__ __forceinline__ void xcd_barrier(const XcdBarrier& b) {
    asm volatile("s_waitcnt vmcnt(0)" ::: "memory");
    __syncthreads();
    if (threadIdx.x == 0) {
        unsigned* bar = b.bar;
        __builtin_amdgcn_s_waitcnt(0);
        unsigned nloc = b.st[0], nx = b.st[1];
        if (nloc == 0u) { xcd_barrier_complete(bar, b.x, nloc, nx); b.st[0] = nloc; b.st[1] = nx; }
        const unsigned old = xb_add(&bar[XB_XSUB(b.x)], 1u);
        const unsigned gen = old / nloc;
        if (old + 1u == (gen + 1u) * nloc) {
            __builtin_amdgcn_fence(__ATOMIC_RELEASE, "agent");
            asm volatile("s_waitcnt vmcnt(0)" ::: "memory");
            const unsigned og = xb_add(&bar[XB_TOP], 1u);
            const unsigned tg = og / nx;
            if (og + 1u == (tg + 1u) * nx) xb_add(&bar[XB_TOPGEN], 1u);
            else XB_SPIN(xb_ld(&bar[XB_TOPGEN]) == tg, bar);
            __builtin_amdgcn_fence(__ATOMIC_ACQUIRE, "agent");
            xb_add(&bar[XB_XGEN(b.x)], 1u);
            asm volatile("s_waitcnt vmcnt(0)" ::: "memory");
        } else {
            XB_SPIN(xb_ld(&bar[XB_XGEN(b.x)]) == gen, bar);
            __builtin_amdgcn_fence(__ATOMIC_ACQUIRE, "agent");
            asm volatile("s_waitcnt vmcnt(0)" ::: "memory");
        }
    }
    __syncthreads();
}

struct Args { const float* in[22]; float* out; unsigned char* ws; int step_lo, step_hi; };

struct Frame {
    LAS unsigned char* lds;
    int tid, lane, wave, G;
    const float* const* in;
    float* out; unsigned char* ws;
};

__device__ __forceinline__ void frame_site(Frame& F, const Args& args) { int t = threadIdx.x; asm volatile("" : "+v"(t)); F.tid = t; F.lane = t & 63; F.wave = __builtin_amdgcn_readfirstlane(t >> 6);
    int z; asm volatile("s_mov_b32 %0, 0" : "=s"(z));
    F.in = args.in + z; F.ws = args.ws + z; F.out = args.out + z; }
__device__ __forceinline__ void frame_tid(Frame& F) { int t = threadIdx.x; asm volatile("" : "+v"(t)); F.tid = t; F.lane = t & 63; F.wave = __builtin_amdgcn_readfirstlane(t >> 6); }
enum { I_X = 0, I_C, I_CTX, I_CCTX, I_ADAW, I_ADAB, I_NORMG, I_F1W13, I_F1W2, I_F2W13, I_F2W2, I_WIN, I_WOUT, I_SGNG, I_SGW, I_SGB, I_CONVW, I_CONVB, I_GATEB, I_MNG, I_RPB, I_FNG };

__device__ __forceinline__ void p0_transpose_item(const float* W, int K, int N, bf16* WT, int k0, int n0, int dst_row0, LAS float* scr, int lane) {
#pragma unroll 8
    for (int i = 0; i < 32; ++i) { const int kk = 2 * i + (lane >> 5); scr[kk * 33 + (lane & 31)] = W[(size_t)(k0 + kk) * N + n0 + (lane & 31)]; }
    LDS_FENCE();
    const int c = lane & 7;
#pragma unroll
    for (int j = 0; j < 4; ++j) { const int n = (lane >> 3) + 8 * j; const LAS float* s = scr + (8 * c) * 33 + n;
        u32x4 o; o.x = pk2(s[0 * 33], s[1 * 33]); o.y = pk2(s[2 * 33], s[3 * 33]); o.z = pk2(s[4 * 33], s[5 * 33]); o.w = pk2(s[6 * 33], s[7 * 33]);
        *(u32x4*)(WT + (size_t)(dst_row0 + n) * K + k0 + 8 * c) = o; }
    LDS_FENCE();
}
struct CvtItem { const float* src; bf16* dst; int N, K, d0, d1; bool ok; };
__device__ __forceinline__ void cvt_load(const CvtItem& c, f32x4 (&v)[16]) {
#pragma unroll
    for (int i = 0; i < 8; ++i) {
        v[2 * i] = __builtin_nontemporal_load((const f32x4*)(c.src + (size_t)(8 * i) * c.N));
        v[2 * i + 1] = __builtin_nontemporal_load((const f32x4*)(c.src + (size_t)(8 * i + 1) * c.N)); }
}
__device__ __forceinline__ void cvt_store(const CvtItem& c, const f32x4 (&v)[16], LAS unsigned* tile, int lane) {
    const int a = lane & 15, kq = lane >> 4, nl = 4 * a;
#pragma unroll
    for (int i = 0; i < 8; ++i)
#pragma unroll
        for (int j = 0; j < 4; ++j) tile[(nl + j) * 36 + 4 * i + kq] = pk2(v[2 * i][j], v[2 * i + 1][j]);
    LDS_FENCE();
#pragma unroll
    for (int it = 0; it < 8; ++it) { const int idx = it * 64 + lane, n = idx >> 3, seg = idx & 7;
        const u32x4 o = *(const LAS u32x4*)(tile + n * 36 + 4 * seg);
        const int drow = n < 32 ? c.d0 + n : c.d1 + (n - 32);
        if (n < 32 || c.d1 >= 0) __builtin_nontemporal_store(o, (u32x4*)(c.dst + (size_t)drow * c.K + 8 * seg)); }
    LDS_FENCE();
}
__device__ __forceinline__ CvtItem cvt_make(const float* W, int K, int N, bf16* WT, int k0, int n0, int d0, int d1, int lane) {
    const int a = lane & 15, kq = lane >> 4, nl = 4 * a; CvtItem c;
    c.ok = (n0 + nl) < N; c.src = W + (size_t)(k0 + 2 * kq) * N + n0 + (c.ok ? nl : 0); c.dst = WT + k0; c.N = N; c.K = K; c.d0 = d0; c.d1 = d1; return c;
}
constexpr int CV_13 = 32 * 176, CV_2 = 88 * 32, CV_IN = 32 * 105, CV_OUT = 32 * 32, CV_LAYER = 2 * CV_13 + 2 * CV_2 + CV_IN + CV_OUT;
__device__ __forceinline__ int w13_dst(int n) { return n < DFF ? (n >> 7) * 256 + (n & 127) : ((n - DFF) >> 7) * 256 + 128 + ((n - DFF) & 127); }
__device__ __forceinline__ int win_dst(int n) { return n < 5120 ? n : (n < 5152 ? 6656 + (n - 5120) : n - 32); }
__device__ __forceinline__ CvtItem convert_desc(Frame& F, int l, int r, int lane) {
    if (r < 2 * CV_13) { const int f = r / CV_13; r %= CV_13; const int kb = r / 176, nb = r % 176;
        return cvt_make(F.in[f ? I_F2W13 : I_F1W13] + (size_t)l * D * 2 * DFF, D, 2 * DFF, (bf16*)(F.ws + WS_W13T + (size_t)(l * 2 + f) * SZ_W13T), kb * 64, nb * 64, w13_dst(nb * 64), w13_dst(nb * 64 + 32), lane); }
    r -= 2 * CV_13;
    if (r < 2 * CV_2) { const int f = r / CV_2; r %= CV_2; const int kb = r / 32, nb = r % 32;
        return cvt_make(F.in[f ? I_F2W2 : I_F1W2] + (size_t)l * DFF * D, DFF, D, (bf16*)(F.ws + WS_W2T + (size_t)(l * 2 + f) * SZ_W2T), kb * 64, nb * 64, nb * 64, nb * 64 + 32, lane); }
    r -= 2 * CV_2;
    if (r < CV_IN) { const int kb = r / 105, nb = r % 105;
        return cvt_make(F.in[I_WIN] + (size_t)l * D * DIN, D, DIN, (bf16*)(F.ws + WS_WINT + (size_t)l * SZ_WINT), kb * 64, nb * 64, win_dst(nb * 64), nb * 64 + 32 < DIN ? win_dst(nb * 64 + 32) : -1, lane); }
    r -= CV_IN;
    const int kb = r / 32, nb = r % 32;
    return cvt_make(F.in[I_WOUT] + (size_t)l * D * D, D, D, (bf16*)(F.ws + WS_WOUTT + (size_t)l * SZ_WOUTT), kb * 64, nb * 64, nb * 64, nb * 64 + 32, lane);
}
__device__ __forceinline__ void convert_run(Frame& F, int first, int end, int step) {
    LAS unsigned* tile = (LAS unsigned*)(F.lds + F.wave * 16384);
    if (first >= end) return;
    f32x4 va[16], vb[16];
    CvtItem ca = convert_desc(F, first / CV_LAYER, first % CV_LAYER, F.lane), cb;
    cvt_load(ca, va);
    for (int it = first; it < end; it += 2 * step) {
        const bool hb = it + step < end;
        if (hb) { cb = convert_desc(F, (it + step) / CV_LAYER, (it + step) % CV_LAYER, F.lane); cvt_load(cb, vb); }
        cvt_store(ca, va, tile, F.lane);
        if (!hb) break;
        const bool ha = it + 2 * step < end;
        if (ha) { ca = convert_desc(F, (it + 2 * step) / CV_LAYER, (it + 2 * step) % CV_LAYER, F.lane); cvt_load(ca, va); }
        cvt_store(cb, vb, tile, F.lane);
        if (!ha) break;
    }
}
constexpr int CV_SLOTS = 84 + 133 + 84, CV_PER_SLOT = (CV_LAYER + CV_SLOTS - 1) / CV_SLOTS;
__device__ __forceinline__ void convert_slot(Frame& F, int l, int slot) {
    const int it0 = slot * CV_PER_SLOT, it1 = (it0 + CV_PER_SLOT) < CV_LAYER ? (it0 + CV_PER_SLOT) : CV_LAYER;
    for (int rc = 0; rc < REP_CVT; ++rc) convert_run(F, l * CV_LAYER + it0 + F.wave, l * CV_LAYER + it1, NWAVES);
}
__device__ __forceinline__ void p0_prologue(Frame& F) {
    const int gw = blockIdx.x * NWAVES + F.wave, NGW = F.G * NWAVES;
    const int gt = blockIdx.x * NTHR + F.tid, NGT = F.G * NTHR;
    { const f32x4* x4 = (const f32x4*)F.in[I_X]; const f32x4* c4 = (const f32x4*)F.in[I_CTX]; f32x4* h4 = (f32x4*)(F.ws + WS_H);
      const int nx = SEQ * D / 4, nc = CTXL * D / 4;
      for (int i = gt; i < nx + nc; i += NGT) h4[i] = i < nx ? x4[i] : c4[i - nx]; }
    { float* rt = (float*)(F.ws + WS_ROPE);
      for (int i = gt; i < 128 * 32; i += NGT) { const int pos = i >> 5, fi = i & 31; const float fr = exp2f(-(float)fi * (13.287712379549449f / 32.0f)); float s, c; sincosf((float)pos * fr, &s, &c); rt[2 * i] = c; rt[2 * i + 1] = s; }
      const float* sw = F.in[I_SGW]; bf16* so = (bf16*)(F.ws + WS_SGW);
      for (int i = gt; i < DEPTH * 4 * 128 * 128 / 2; i += NGT) ((unsigned*)so)[i] = pk2(sw[2 * i], sw[2 * i + 1]); }
    { LAS float* sc = (LAS float*)(F.lds);
      LAS float* red = (LAS float*)(F.lds + 16384);
      for (int i = F.tid; i < 2 * D; i += NTHR) { const float v = i < D ? F.in[I_C][i] : F.in[I_CCTX][i - D]; sc[i] = silu_f(v); }
      __syncthreads();
      for (int it = blockIdx.x; it < DEPTH * 72; it += F.G) {
          const int l = it / 72, cg = it % 72, n0 = cg * 256 + 4 * F.lane;
          const float* W = F.in[I_ADAW] + (size_t)l * D * NMODV + n0;
          f32x4 al = {0.f, 0.f, 0.f, 0.f}, ac = {0.f, 0.f, 0.f, 0.f};
          const int kb = F.wave * 256;
#pragma unroll 8
          for (int k = 0; k < 256; ++k) { const f32x4 w = *(const f32x4*)(W + (size_t)(kb + k) * NMODV); al += w * sc[kb + k]; ac += w * sc[D + kb + k]; }
#pragma unroll
          for (int j = 0; j < 4; ++j) { red[(F.wave * 256 + 4 * F.lane + j) * 2] = al[j]; red[(F.wave * 256 + 4 * F.lane + j) * 2 + 1] = ac[j]; }
          __syncthreads();
          { const int col = F.tid >> 1, t = F.tid & 1; float s = 0.f;
#pragma unroll
            for (int w = 0; w < 8; ++w) s += red[(w * 256 + col) * 2 + t];
            const int n = cg * 256 + col; s += F.in[I_ADAB][l * NMODV + n];
            const int ch = n >> 11; if (ch == 2 || ch == 8) s *= 0.5f;
            ((float*)(F.ws + WS_MOD))[(size_t)(l * 2 + t) * NMODV + n] = s; }
          __syncthreads();
      }
    }
    convert_run(F, gw, ((F.G == 256) ? 1 : DEPTH) * CV_LAYER, NGW);
}

__device__ __forceinline__ void norm_phase(Frame& F, const float* g, const float* modl  , int ishift, int iscale, int M, int nparts) {
    const int gw = blockIdx.x * NWAVES + F.wave, NGW = F.G * NWAVES;
    float* H = (float*)(F.ws + WS_H); bf16* A = (bf16*)(F.ws + WS_ABUF);
    for (int row = gw; row < M; row += NGW) {
        const int t = row >= SEQ ? 1 : 0;
        const float* sh = modl + (size_t)t * NMODV + ishift * D; const float* scl = modl + (size_t)t * NMODV + iscale * D;
        const f32x4* xr = (const f32x4*)(H + (size_t)row * D) + F.lane;
        f32x4 v[8]; float s = 0.f;
#pragma unroll
        for (int j = 0; j < 8; ++j) v[j] = xr[64 * j];
        if (t && nparts > 0) {
            const f32x4* sl = (const f32x4*)(F.ws + WS_SLAB) + (size_t)(row - SEQ) * (D / 4) + F.lane;
            for (int p = 0; p < nparts; ++p) {
#pragma unroll
                for (int j = 0; j < 8; ++j) v[j] += sl[(size_t)p * 256 * (D / 4) + 64 * j]; }
            f32x4* xw = (f32x4*)(H + (size_t)row * D) + F.lane;
#pragma unroll
            for (int j = 0; j < 8; ++j) xw[64 * j] = v[j];
        }
#pragma unroll
        for (int j = 0; j < 8; ++j) s += (v[j][0] * v[j][0] + v[j][1] * v[j][1]) + (v[j][2] * v[j][2] + v[j][3] * v[j][3]);
        const float rstd = rsqrtf(wsum(s) * (1.0f / D) + EPS);
        u32x2* o = (u32x2*)(A + (size_t)row * D) + F.lane;
#pragma unroll
        for (int j = 0; j < 8; ++j) { const int c = 4 * F.lane + 256 * j;
            const f32x4 gg = *(const f32x4*)(g + c), ss = *(const f32x4*)(scl + c), hh = *(const f32x4*)(sh + c);
            const f32x4 y = (v[j] * rstd) * gg * (ss + 1.0f) + hh;
            u32x2 w; w.x = pk2(y[0], y[1]); w.y = pk2(y[2], y[3]); o[64 * j] = w; }
    }
}
__device__ __forceinline__ void final_norm_phase(Frame& F) {
    const int gw = blockIdx.x * NWAVES + F.wave, NGW = F.G * NWAVES;
    const float* H = (const float*)(F.ws + WS_H); const float* g = F.in[I_FNG];
    for (int row = gw; row < SEQ; row += NGW) {
        const f32x4* xr = (const f32x4*)(H + (size_t)row * D) + F.lane;
        f32x4 v[8]; float s = 0.f;
#pragma unroll
        for (int j = 0; j < 8; ++j) { v[j] = xr[64 * j]; s += (v[j][0] * v[j][0] + v[j][1] * v[j][1]) + (v[j][2] * v[j][2] + v[j][3] * v[j][3]); }
        const float rstd = rsqrtf(wsum(s) * (1.0f / D) + EPS);
        f32x4* o = (f32x4*)(F.out + (size_t)row * D) + F.lane;
#pragma unroll
        for (int j = 0; j < 8; ++j) o[64 * j] = (v[j] * rstd) * *(const f32x4*)(g + 4 * F.lane + 256 * j);
    }
}

__device__ __forceinline__ void tile_rows_out(const LAS short* tile, bf16* dst, int row0, int tokb, int lane) {
    LDS_FENCE();
#pragma unroll
    for (int it = 0; it < 8; ++it) { const int idx = it * 64 + lane, r = idx >> 3, seg = idx & 7;
        const bf16x8 v = *(const LAS bf16x8*)(tile + r * 72 + 8 * seg);
        *(bf16x8*)(dst + (size_t)(row0 + r) * MTOK + tokb + 8 * seg) = v; }
    LDS_FENCE();
}
__device__ __forceinline__ void prep_transpose_item(const bf16* P, int c0, bf16* dst, int drow0, int tb, LAS short* tile, int lane) {
#pragma unroll
    for (int it = 0; it < 8; ++it) { const int idx = it * 64 + lane, tok = idx >> 3, seg = idx & 7;
        const bf16x8 v = *(const bf16x8*)(P + (size_t)(tb * 64 + tok) * DINP + c0 + 8 * seg);
#pragma unroll
        for (int j = 0; j < 8; ++j) tile[(8 * seg + j) * 72 + tok] = v[j]; }
    tile_rows_out(tile, dst, drow0, tb * 64, lane);
}
__device__ __forceinline__ void prep_conv_item(Frame& F, const bf16* P, const float* cw  , const float* cb, int tb, int cg, LAS short* tile, int lane) {
    const int i = lane & 31, ts = lane >> 5, ch0 = cg * 64 + i, ch1 = ch0 + 32;
    const bool isK = cg >= 16; const int half = cg & 1;
    const int tok0 = tb * 64, t0 = tok0 + 32 * ts;
    const int seq_lo = tok0 < SEQ ? 0 : SEQ, seq_hi = tok0 < SEQ ? SEQ : MTOK;
    float w0[5], w1[5];
#pragma unroll
    for (int j = 0; j < 5; ++j) { w0[j] = cw[j * 2048 + ch0]; w1[j] = cw[j * 2048 + ch1]; }
    const float b0 = cb[ch0], b1 = cb[ch1];
    const bf16* src = P + PC_MQ;
    float xa[36], xb[36];
#pragma unroll
    for (int j = 0; j < 36; ++j) { const int t = t0 + j - 2; const bool ok = t >= seq_lo && t < seq_hi;
        xa[j] = ok ? bf2f((short)src[(size_t)t * DINP + ch0]) : 0.f; xb[j] = ok ? bf2f((short)src[(size_t)t * DINP + ch1]) : 0.f; }
    const float* rope = (const float*)(F.ws + WS_ROPE);
    const bool lat = tok0 < SEQ;
    bf16* dstn = (bf16*)(F.ws + (isK ? WS_KC : WS_QC));
    const int chn0 = ch0 & 1023;
    const float qs = isK ? 1.0f : 0.08838834764831845f;
#pragma unroll
    for (int tt = 0; tt < 32; ++tt) {
        const int t = t0 + tt;
        float y0 = b0, y1 = b1;
#pragma unroll
        for (int j = 0; j < 5; ++j) { y0 += w0[j] * xa[tt + j]; y1 += w1[j] * xb[tt + j]; }
        y0 = silu_f(y0); y1 = silu_f(y1);
        if (lat) { const int pos = half ? (t & 63) : (t >> 6); const f32x2 cs2 = *(const f32x2*)(rope + (pos * 32 + i) * 2);
            const float r0 = y0 * cs2[0] - y1 * cs2[1], r1 = y0 * cs2[1] + y1 * cs2[0]; y0 = r0; y1 = r1; }
        y0 *= qs; y1 *= qs;
        const short o0 = f2bf(y0), o1 = f2bf(y1);
        dstn[(size_t)t * 1024 + chn0] = (bf16)o0; dstn[(size_t)t * 1024 + chn0 + 32] = (bf16)o1;
        if (isK) { tile[i * 72 + 32 * ts + tt] = o0; tile[(i + 32) * 72 + 32 * ts + tt] = o1; }
    }
    if (isK) tile_rows_out(tile, (bf16*)(F.ws + WS_KCT), (cg - 16) * 64, tok0, lane);
}
__device__ __forceinline__ void prep_sgu_item(Frame& F, const bf16* P, const float* ng, int tb, int cg, LAS short* tile, int lane) {
    const int tok0 = tb * 64;
    float p[64];
#pragma unroll
    for (int tok = 0; tok < 64; ++tok) {
        const bf16x8 v = *(const bf16x8*)(P + (size_t)(tok0 + tok) * DINP + PC_V + 8 * lane); float sq = 0.f;
#pragma unroll
        for (int j = 0; j < 8; ++j) { const float gl = gelu_tanh(bf2f(v[j])); sq += gl * gl; }
        p[tok] = sq;
    }
#pragma unroll
    for (int o = 32; o >= 1; o >>= 1) {
        const bool up = (lane & o) != 0;
#pragma unroll
        for (int i2 = 0; i2 < o; ++i2) { const float lo_ = p[i2], hi_ = p[i2 + o]; const float send = up ? lo_ : hi_, keep = up ? hi_ : lo_; p[i2] = keep + __shfl_xor(send, o); }
    }
    const float myr = rsqrtf(p[0] * (1.0f / 512.0f) + EPS);
    const bf16* rowp = P + (size_t)(tok0 + lane) * DINP + PC_V + cg * 64;
#pragma unroll
    for (int seg = 0; seg < 8; ++seg) { const bf16x8 v = *(const bf16x8*)(rowp + 8 * seg);
#pragma unroll
        for (int j = 0; j < 8; ++j) tile[(8 * seg + j) * 72 + lane] = f2bf(gelu_tanh(bf2f(v[j])) * myr * ng[cg * 64 + 8 * seg + j]); }
    tile_rows_out(tile, (bf16*)(F.ws + WS_VNT), cg * 64, tok0, lane);
}
__device__ __forceinline__ void prep_phase(Frame& F, int l) {
    const int gw = blockIdx.x * NWAVES + F.wave, NGW = F.G * NWAVES;
    const bf16* P = (const bf16*)(F.ws + WS_P);
    LAS short* tile = (LAS short*)(F.lds + F.wave * 16384);
    constexpr int NTB = MTOK / 64;
    constexpr int N_CONV = NTB * 32, N_SGU = NTB * 8, N_MVT = NTB * 16, N_NAVT = NTB * 8;
    for (int it = gw; it < N_CONV + N_SGU + N_MVT + N_NAVT; it += NGW) {
        int r = it;
        if (r < N_CONV) { prep_conv_item(F, P, F.in[I_CONVW] + (size_t)l * 5 * 2048, F.in[I_CONVB] + (size_t)l * 2048, r >> 5, r & 31, tile, F.lane); continue; } r -= N_CONV;
        if (r < N_SGU) { prep_sgu_item(F, P, F.in[I_SGNG] + (size_t)l * 512, r >> 3, r & 7, tile, F.lane); continue; } r -= N_SGU;
        if (r < N_MVT) { prep_transpose_item(P, PC_MV + (r & 15) * 64, (bf16*)(F.ws + WS_MVT), (r & 15) * 64, r >> 4, tile, F.lane); continue; } r -= N_MVT;
        prep_transpose_item(P, PC_NV + (r & 7) * 64, (bf16*)(F.ws + WS_NAVT), (r & 7) * 64, r >> 3, tile, F.lane);
    }
}

struct MG { float i_f[2], b_f[2], i_b[2], b_b[2]; float bl_f, bl_b; };
__device__ __forceinline__ void mlstm_gates(const float* G, int lane, MG& g) {
    float lf[2], lb[2];
#pragma unroll
    for (int x = 0; x < 2; ++x) { const float* p = G + (size_t)(lane + 64 * x) * 32; g.i_f[x] = p[0]; lf[x] = logsig(p[8]); g.i_b[x] = p[16]; lb[x] = logsig(p[24]); }
    const float s0 = scan_up_add(lf[0], lane), t0 = __shfl(s0, 63), s1 = scan_up_add(lf[1], lane) + t0;
    g.b_f[0] = s0; g.b_f[1] = s1; g.bl_f = __shfl(s1, 63);
    const float r1 = scan_down_add(lb[1], lane), t1 = __shfl(r1, 0), r0 = scan_down_add(lb[0], lane) + t1;
    g.b_b[0] = r0; g.b_b[1] = r1; g.bl_b = __shfl(r0, 0);
}
__device__ __forceinline__ void mlstm_local_unit(Frame& F, int c, int h, LAS float* wsl) {
    const int lane = F.lane, w = F.wave, fr = lane & 15, fq = lane >> 4, tok0 = c * 128;
    const int posf = (c + 2) % NCHUNK, posb = 65 - c;
    MG g; mlstm_gates((const float*)(F.ws + WS_GATES) + (size_t)tok0 * 32 + h, lane, g);
    float gf[2], gb[2];
#pragma unroll
    for (int x = 0; x < 2; ++x) { gf[x] = g.bl_f - g.b_f[x] + g.i_f[x]; gb[x] = g.bl_b - g.b_b[x] + g.i_b[x]; }
    const float gmf = wmax(fmaxf(gf[0], gf[1])), gmb = wmax(fmaxf(gb[0], gb[1]));
    wsl[lane] = __expf(gf[0] - gmf); wsl[64 + lane] = __expf(gf[1] - gmf); wsl[128 + lane] = __expf(gb[0] - gmb); wsl[192 + lane] = __expf(gb[1] - gmb);
    LDS_FENCE();
    const bf16* krow = (const bf16*)(F.ws + WS_KCT) + (size_t)(h * 128 + 16 * w + fr) * MTOK + tok0 + 8 * fq;
    bf16x8 yf[4], yb[4]; float unf = 0.f, unb = 0.f;
#pragma unroll
    for (int ks = 0; ks < 4; ++ks) { const bf16x8 raw = *(const bf16x8*)(krow + 32 * ks);
        const f32x4 wf0 = *(const LAS f32x4*)(wsl + 32 * ks + 8 * fq), wf1 = *(const LAS f32x4*)(wsl + 32 * ks + 8 * fq + 4);
        const f32x4 wb0 = *(const LAS f32x4*)(wsl + 128 + 32 * ks + 8 * fq), wb1 = *(const LAS f32x4*)(wsl + 128 + 32 * ks + 8 * fq + 4);
        float a[8], b[8];
#pragma unroll
        for (int j = 0; j < 8; ++j) { const float kv = bf2f(raw[j]); a[j] = kv * (j < 4 ? wf0[j & 3] : wf1[j & 3]); b[j] = kv * (j < 4 ? wb0[j & 3] : wb1[j & 3]); unf += a[j]; unb += b[j]; }
        u32x4 pa, pb; pa.x = pk2(a[0], a[1]); pa.y = pk2(a[2], a[3]); pa.z = pk2(a[4], a[5]); pa.w = pk2(a[6], a[7]);
        pb.x = pk2(b[0], b[1]); pb.y = pk2(b[2], b[3]); pb.z = pk2(b[4], b[5]); pb.w = pk2(b[6], b[7]);
        yf[ks] = __builtin_bit_cast(bf16x8, pa); yb[ks] = __builtin_bit_cast(bf16x8, pb); }
    float* uf = (float*)(F.ws + WS_UT) + ((size_t)((0 * NCHUNK + posf) * 8 + h) * 128) * 128;
    float* ub = (float*)(F.ws + WS_UT) + ((size_t)((1 * NCHUNK + posb) * 8 + h) * 128) * 128;
#pragma unroll
    for (int et = 0; et < 8; ++et) {
        const bf16* vrow = (const bf16*)(F.ws + WS_MVT) + (size_t)(h * 128 + 16 * et + fr) * MTOK + tok0 + 8 * fq;
        f32x4 af = {0.f, 0.f, 0.f, 0.f}, ab = {0.f, 0.f, 0.f, 0.f};
#pragma unroll
        for (int ks = 0; ks < 4; ++ks) { const bf16x8 xf = *(const bf16x8*)(vrow + 32 * ks); af = mfma16(xf, yf[ks], af); ab = mfma16(xf, yb[ks], ab); }
#pragma unroll
        for (int r = 0; r < 4; ++r) { uf[(size_t)(16 * et + 4 * fq + r) * 128 + 16 * w + fr] = af[r]; ub[(size_t)(16 * et + 4 * fq + r) * 128 + 16 * w + fr] = ab[r]; }
    }
    unf = qsum(unf); unb = qsum(unb);
    if (fq == 0) { ((float*)(F.ws + WS_UN))[((size_t)(0 * NCHUNK + posf) * 8 + h) * 128 + 16 * w + fr] = unf; ((float*)(F.ws + WS_UN))[((size_t)(1 * NCHUNK + posb) * 8 + h) * 128 + 16 * w + fr] = unb; }
    if (w == 0 && lane == 0) { float* bg = (float*)(F.ws + WS_BLGM);
        bg[((0 * NCHUNK + posf) * 8 + h) * 2] = g.bl_f; bg[((0 * NCHUNK + posf) * 8 + h) * 2 + 1] = gmf; bg[((1 * NCHUNK + posb) * 8 + h) * 2] = g.bl_b; bg[((1 * NCHUNK + posb) * 8 + h) * 2 + 1] = gmb; }
    LDS_FENCE();
}
__device__ __forceinline__ void scan_phase(Frame& F) {
    const float* UT = (const float*)(F.ws + WS_UT); const float* UN = (const float*)(F.ws + WS_UN); const float* BG = (const float*)(F.ws + WS_BLGM);
    bf16* CT = (bf16*)(F.ws + WS_CT); float* CN = (float*)(F.ws + WS_CN); float* CM = (float*)(F.ws + WS_CM);
    const int NT = F.G * NTHR;
    for (int gid = blockIdx.x * NTHR + F.tid; gid < 65536 + 512; gid += NT) {
        if (gid < 65536) {
            const int d4 = gid & 31, e = (gid >> 5) & 127, h = (gid >> 12) & 7, dir = gid >> 15;
            const size_t base = ((size_t)(dir * NCHUNK * 8 + h) * 128 + e) * 128 + d4 * 4, pstride = (size_t)8 * 128 * 128;
            f32x4 C = {0.f, 0.f, 0.f, 0.f}; float m = 0.f;
#pragma unroll 6
            for (int pos = 0; pos < NCHUNK; ++pos) {
                u32x2 o; o.x = pk2(C[0], C[1]); o.y = pk2(C[2], C[3]); *(u32x2*)(CT + base + pos * pstride) = o;
                if (e == 0 && d4 == 0) CM[(dir * NCHUNK + pos) * 8 + h] = m;
                const float bl = BG[((dir * NCHUNK + pos) * 8 + h) * 2], gm = BG[((dir * NCHUNK + pos) * 8 + h) * 2 + 1];
                const float mn = fmaxf(bl + m, gm), dec = __expf(bl + m - mn), sc = __expf(gm - mn);
                const f32x4 u = *(const f32x4*)(UT + base + pos * pstride);
                C = C * dec + u * sc; m = mn;
            }
        } else {
            const int k = gid - 65536, d4 = k & 31, h = (k >> 5) & 7, dir = k >> 8;
            const size_t base = ((size_t)(dir * NCHUNK * 8 + h)) * 128 + d4 * 4, pstride = (size_t)8 * 128;
            f32x4 C = {0.f, 0.f, 0.f, 0.f}; float m = 0.f;
            for (int pos = 0; pos < NCHUNK; ++pos) {
                *(f32x4*)(CN + base + pos * pstride) = C;
                const float bl = BG[((dir * NCHUNK + pos) * 8 + h) * 2], gm = BG[((dir * NCHUNK + pos) * 8 + h) * 2 + 1];
                const float mn = fmaxf(bl + m, gm), dec = __expf(bl + m - mn), sc = __expf(gm - mn);
                const f32x4 u = *(const f32x4*)(UN + base + pos * pstride);
                C = C * dec + u * sc; m = mn;
            }
        }
    }
}
constexpr int MO_K = 0, MO_V = 32768, MO_CF = 65536, MO_CB = 98304, MO_COL = 131072;
__device__ __forceinline__ void mlstm_out_unit(Frame& F, int l, int c, int h) {
    int tid_ = F.tid; asm volatile("" : "+v"(tid_));
    const int tid = tid_, lane = tid & 63, w = __builtin_amdgcn_readfirstlane(tid >> 6), fr = lane & 15, fq = lane >> 4, tok0 = c * 128, t = 16 * w + fr;
    const int posf = (c + 2) % NCHUNK, posb = 65 - c;
    LAS unsigned char* lds = F.lds;
    const bf16* ctf = (const bf16*)(F.ws + WS_CT) + ((size_t)((0 * NCHUNK + posf) * 8 + h) * 128) * 128;
    const bf16* ctb = (const bf16*)(F.ws + WS_CT) + ((size_t)((1 * NCHUNK + posb) * 8 + h) * 128) * 128;
    bf16x8 gk[4], gv[4], gcf[4], gcb[4];
#pragma unroll
    for (int i = 0; i < 4; ++i) { const int idx = tid + 512 * i, row = idx >> 4, ch = idx & 15;
        gk[i] = *(const bf16x8*)((const bf16*)(F.ws + WS_KC) + (size_t)(tok0 + row) * 1024 + h * 128 + 8 * ch);
        gv[i] = *(const bf16x8*)((const bf16*)(F.ws + WS_MVT) + (size_t)(h * 128 + row) * MTOK + tok0 + 8 * ch);
        gcf[i] = *(const bf16x8*)(ctf + row * 128 + 8 * ch); gcb[i] = *(const bf16x8*)(ctb + row * 128 + 8 * ch); }
    __builtin_amdgcn_sched_barrier(0);
    const bf16* qrow = (const bf16*)(F.ws + WS_QC) + (size_t)(tok0 + t) * 1024 + h * 128 + 8 * fq;
    bf16x8 qf[4];
#pragma unroll
    for (int ks = 0; ks < 4; ++ks) qf[ks] = *(const bf16x8*)(qrow + 32 * ks);
    MG g; mlstm_gates((const float*)(F.ws + WS_GATES) + (size_t)tok0 * 32 + h, lane, g);
    const float mf = ((const float*)(F.ws + WS_CM))[(0 * NCHUNK + posf) * 8 + h], mb = ((const float*)(F.ws + WS_CM))[(1 * NCHUNK + posb) * 8 + h];
    float cf[2], cb[2];
#pragma unroll
    for (int x = 0; x < 2; ++x) { cf[x] = g.i_f[x] - g.b_f[x]; cb[x] = g.i_b[x] - g.b_b[x]; }
    float pm[2], sm[2];
    { const float p0 = scan_up_max(cf[0], lane), tt = __shfl(p0, 63), p1 = fmaxf(scan_up_max(cf[1], lane), tt); pm[0] = p0; pm[1] = p1;
      const float q1 = scan_down_max(cb[1], lane), uu = __shfl(q1, 0), q0 = fmaxf(scan_down_max(cb[0], lane), uu); sm[0] = q0; sm[1] = q1; }
    LAS float* wsl = (LAS float*)(lds + MO_COL + 1024 * w);
    wsl[lane] = cf[0]; wsl[64 + lane] = cf[1]; wsl[128 + lane] = cb[0]; wsl[192 + lane] = cb[1];
    const int xh = w >> 2, sl = 16 * (w & 3) + fr;
    const float Mf = fmaxf(__shfl(xh ? pm[1] : pm[0], sl), mf), Mb = fmaxf(__shfl(xh ? sm[1] : sm[0], sl), mb);
    const float bft = __shfl(xh ? g.b_f[1] : g.b_f[0], sl), bbt = __shfl(xh ? g.b_b[1] : g.b_b[0], sl);
    const float rowf = -Mf, a_f = __expf(mf - Mf), fl_f = __expf(-(bft + Mf)), rowb = -Mb, a_b = __expf(mb - Mb), fl_b = __expf(-(bbt + Mb));
    __builtin_amdgcn_sched_barrier(0);
#pragma unroll
    for (int i = 0; i < 4; ++i) { const int idx = tid + 512 * i, row = idx >> 4, ch = idx & 15; const int o = row * 256 + ((ch ^ (row & 15)) << 4);
        *(LAS bf16x8*)(lds + MO_K + o) = gk[i]; *(LAS bf16x8*)(lds + MO_V + o) = gv[i]; *(LAS bf16x8*)(lds + MO_CF + o) = gcf[i]; *(LAS bf16x8*)(lds + MO_CB + o) = gcb[i]; }
    asm volatile("s_waitcnt lgkmcnt(0)" ::: "memory"); __syncthreads();
    const int rbase = fr * 256;
    bf16x8 pf[4], pb[4]; float dsf = 0.f, dsb = 0.f;
#pragma unroll
    for (int kb = 0; kb < 4; ++kb) {
        float vf[8], vb[8];
#pragma unroll
        for (int hh = 0; hh < 2; ++hh) { const int st = 2 * kb + hh;
            f32x4 S = {0.f, 0.f, 0.f, 0.f};
#pragma unroll
            for (int ks = 0; ks < 4; ++ks) S = mfma16(*(const LAS bf16x8*)(lds + MO_K + st * 4096 + rbase + (((4 * ks + fq) ^ fr) << 4)), qf[ks], S);
            const f32x4 c4f = *(const LAS f32x4*)(wsl + 16 * st + 4 * fq), c4b = *(const LAS f32x4*)(wsl + 128 + 16 * st + 4 * fq);
#pragma unroll
            for (int r = 0; r < 4; ++r) { const int s = 16 * st + 4 * fq + r;
                const float ef = (s <= t) ? __expf(rowf + c4f[r]) : 0.f, eb = (s >= t) ? __expf(rowb + c4b[r]) : 0.f;
                const float p1 = S[r] * ef, p2 = S[r] * eb; vf[4 * hh + r] = p1; vb[4 * hh + r] = p2; dsf += p1; dsb += p2; } }
        u32x4 a, b; a.x = pk2(vf[0], vf[1]); a.y = pk2(vf[2], vf[3]); a.z = pk2(vf[4], vf[5]); a.w = pk2(vf[6], vf[7]);
        b.x = pk2(vb[0], vb[1]); b.y = pk2(vb[2], vb[3]); b.z = pk2(vb[4], vb[5]); b.w = pk2(vb[6], vb[7]);
        pf[kb] = __builtin_bit_cast(bf16x8, a); pb[kb] = __builtin_bit_cast(bf16x8, b);
        __builtin_amdgcn_sched_barrier(0);
    }
    dsf = qsum(dsf); dsb = qsum(dsb);
    const float* nf = (const float*)(F.ws + WS_CN) + ((size_t)(0 * NCHUNK + posf) * 8 + h) * 128; const float* nb = (const float*)(F.ws + WS_CN) + ((size_t)(1 * NCHUNK + posb) * 8 + h) * 128;
    float qnf = 0.f, qnb = 0.f;
#pragma unroll
    for (int ks = 0; ks < 4; ++ks) { const f32x4 n0 = *(const f32x4*)(nf + 32 * ks + 8 * fq), n1 = *(const f32x4*)(nf + 32 * ks + 8 * fq + 4), m0 = *(const f32x4*)(nb + 32 * ks + 8 * fq), m1 = *(const f32x4*)(nb + 32 * ks + 8 * fq + 4);
#pragma unroll
        for (int j = 0; j < 8; ++j) { const float qv = bf2f(qf[ks][j]); qnf += qv * (j < 4 ? n0[j & 3] : n1[j & 3]); qnb += qv * (j < 4 ? m0[j & 3] : m1[j & 3]); } }
    qnf = qsum(qnf); qnb = qsum(qnb);
    const float inv_f = 1.0f / fmaxf(fabsf(a_f * qnf + dsf), fl_f), inv_b = 1.0f / fmaxf(fabsf(a_b * qnb + dsb), fl_b);
    f32x4 hs[8]; float ss = 0.f;
#pragma unroll
    for (int et = 0; et < 8; ++et) {
        f32x4 af = {0.f, 0.f, 0.f, 0.f}, ab = {0.f, 0.f, 0.f, 0.f};
#pragma unroll
        for (int ks = 0; ks < 4; ++ks) { const int o = et * 4096 + rbase + (((4 * ks + fq) ^ fr) << 4);
            af = mfma16(*(const LAS bf16x8*)(lds + MO_CF + o), qf[ks], af); ab = mfma16(*(const LAS bf16x8*)(lds + MO_CB + o), qf[ks], ab); }
        af = af * a_f; ab = ab * a_b;
#pragma unroll
        for (int kb = 0; kb < 4; ++kb) {
            const int o = MO_V + et * 4096 + rbase + 8 * (fq & 1);
            const bf16x8 xf = cat8(*(const LAS bf16x4*)(lds + o + (((4 * kb + (fq >> 1)) ^ fr) << 4)), *(const LAS bf16x4*)(lds + o + (((4 * kb + 2 + (fq >> 1)) ^ fr) << 4)));
            af = mfma16(xf, pf[kb], af); ab = mfma16(xf, pb[kb], ab); }
        hs[et] = af * inv_f + ab * inv_b;
        ss += (hs[et][0] * hs[et][0] + hs[et][1] * hs[et][1]) + (hs[et][2] * hs[et][2] + hs[et][3] * hs[et][3]);
        __builtin_amdgcn_sched_barrier(0);
    }
    ss = qsum(ss);
    const float rstd = rsqrtf(ss * (1.0f / 128.0f) + EPS);
    const float* ng = F.in[I_MNG] + (size_t)l * 1024 + h * 128;
    const bf16* orow = (const bf16*)(F.ws + WS_P) + (size_t)(tok0 + t) * DINP + PC_MO + h * 128;
    bf16* crow = (bf16*)(F.ws + WS_CAT) + (size_t)(tok0 + t) * D + 512 + h * 128;
#pragma unroll
    for (int et = 0; et < 8; ++et) { const int e = 16 * et + 4 * fq; const bf16x4 ov = *(const bf16x4*)(orow + e); const f32x4 gg = *(const f32x4*)(ng + e);
        float y[4];
#pragma unroll
        for (int r = 0; r < 4; ++r) y[r] = sigmoid_f(bf2f(ov[r])) * (hs[et][r] * rstd * gg[r]);
        *(bf16x4*)(crow + e) = pk4(y[0], y[1], y[2], y[3]); }
    asm volatile("s_waitcnt lgkmcnt(0)" ::: "memory"); __syncthreads();
}

__device__ __forceinline__ void sgu_unit(Frame& F, int l, int c, int g) {
    const int lane = F.lane, w = F.wave, fr = lane & 15, fq = lane >> 4, tok0 = c * 128, t = 16 * w + fr;
    const bf16* wrow = (const bf16*)(F.ws + WS_SGW) + ((size_t)(l * 4 + g) * 128 + t) * 128 + 8 * fq;
    bf16x8 yf[4];
#pragma unroll
    for (int ks = 0; ks < 4; ++ks) yf[ks] = *(const bf16x8*)(wrow + 32 * ks);
    const float bs = F.in[I_SGB][(size_t)(l * 4 + g) * 128 + t];
    const bf16* urow = (const bf16*)(F.ws + WS_P) + (size_t)(tok0 + t) * DINP + PC_U + g * 128;
    bf16* crow = (bf16*)(F.ws + WS_CAT) + (size_t)(tok0 + t) * D + g * 128;
#pragma unroll
    for (int ct = 0; ct < 8; ++ct) {
        const bf16* vrow = (const bf16*)(F.ws + WS_VNT) + (size_t)(g * 128 + 16 * ct + fr) * MTOK + tok0 + 8 * fq;
        f32x4 a = {0.f, 0.f, 0.f, 0.f};
#pragma unroll
        for (int ks = 0; ks < 4; ++ks) a = mfma16(*(const bf16x8*)(vrow + 32 * ks), yf[ks], a);
        const int cc = 16 * ct + 4 * fq; const bf16x4 uv = *(const bf16x4*)(urow + cc);
        float y[4];
#pragma unroll
        for (int r = 0; r < 4; ++r) y[r] = gelu_tanh(bf2f(uv[r])) * (a[r] + bs);
        *(bf16x4*)(crow + cc) = pk4(y[0], y[1], y[2], y[3]);
    }
}

constexpr int NA_KL = 0, NA_KC = 73728, NA_VL = 0, NA_VC = 66560, NA_MS = 110592;
template <bool LOCAL> __device__ __forceinline__ void na_unit(Frame& F, const float* rpb  , int r, int h) {
    const int tid = F.tid, lane = F.lane, wave = F.wave, fr = lane & 15, fq = lane >> 4, cb = wave & 3, part = wave >> 2;
    const bf16* P = (const bf16*)(F.ws + WS_P); const bf16* VT = (const bf16*)(F.ws + WS_NAVT);
    LAS unsigned char* lds = F.lds;
    int rs = r - 4; rs = rs < 0 ? 0 : (rs > 120 ? 120 : rs);
    {   bf16x8 kl[8], kc[4];
        if (LOCAL) {
#pragma unroll
            for (int i = 0; i < 8; ++i) { const int idx = tid + 512 * i, row = idx >> 3, ch = idx & 7; const int tok = (rs + (row >> 6)) * 64 + (row & 63);
                kl[i] = *(const bf16x8*)(P + (size_t)tok * DINP + PC_NK + h * 64 + 8 * ch); } }
#pragma unroll
        for (int i = 0; i < 4; ++i) { const int idx = tid + 512 * i, row = idx >> 3, ch = idx & 7;
            kc[i] = *(const bf16x8*)(P + (size_t)(SEQ + row) * DINP + PC_NK + h * 64 + 8 * ch); }
        if (LOCAL) {
#pragma unroll
            for (int i = 0; i < 8; ++i) { const int idx = tid + 512 * i, row = idx >> 3, ch = idx & 7; *(LAS bf16x8*)(lds + NA_KL + row * 144 + 16 * ch) = kl[i]; } }
#pragma unroll
        for (int i = 0; i < 4; ++i) { const int idx = tid + 512 * i, row = idx >> 3, ch = idx & 7; *(LAS bf16x8*)(lds + NA_KC + row * 144 + 16 * ch) = kc[i]; }
    }
    bf16x8 vl[8], vc[4];
    if (LOCAL) {
#pragma unroll
        for (int i = 0; i < 8; ++i) { const int idx = tid + 512 * i, row = idx >> 6, ch = idx & 63;
            vl[i] = *(const bf16x8*)(VT + (size_t)(h * 64 + row) * MTOK + (rs + (ch >> 3)) * 64 + 8 * (ch & 7)); } }
#pragma unroll
    for (int i = 0; i < 4; ++i) { const int idx = tid + 512 * i, row = idx >> 5, ch = idx & 31;
        vc[i] = *(const bf16x8*)(VT + (size_t)(h * 64 + row) * MTOK + SEQ + 8 * ch); }
    const int tokq = (LOCAL ? r * 64 : SEQ + r * 64) + 16 * cb + fr;
    const bf16* qrow = P + (size_t)tokq * DINP + PC_NQ + h * 64 + 8 * fq;
    const bf16x8 qf0 = *(const bf16x8*)qrow, qf1 = *(const bf16x8*)(qrow + 32);
    int kc0 = 16 * cb - 8; kc0 = kc0 < 0 ? 0 : (kc0 > 32 ? 32 : kc0);
    const int qc = 16 * cb + fr; int cs = qc - 8; cs = cs < 0 ? 0 : (cs > 48 ? 48 : cs);
    const bool loc = LOCAL && part == 0;
    constexpr int NT = LOCAL ? 16 : 8;
    asm volatile("s_waitcnt lgkmcnt(0)" ::: "memory"); __syncthreads();
    f32x4 S[NT]; float mx = -1e30f;
    const float* rpbh = rpb + (h * 15 + (rs - r + 7)) * 31 + (kc0 + 4 * fq - qc + 15);
#pragma unroll
    for (int kt = 0; kt < NT; ++kt) {
        const int krow = loc ? (kt >> 1) * 64 + kc0 + 16 * (kt & 1) + fr : (LOCAL ? 16 * kt : 128 * part + 16 * kt) + fr;
        const LAS unsigned char* kp = lds + (loc ? NA_KL : NA_KC) + krow * 144 + 16 * fq;
        f32x4 a = {0.f, 0.f, 0.f, 0.f};
        a = mfma16(*(const LAS bf16x8*)kp, qf0, a); a = mfma16(*(const LAS bf16x8*)(kp + 64), qf1, a);
#pragma unroll
        for (int rr = 0; rr < 4; ++rr) { float v = a[rr] * 0.125f;
            if (loc) { const int kc = kc0 + 4 * fq + 16 * (kt & 1) + rr; const bool valid = kc >= cs && kc < cs + 16;
                const float bias = valid ? rpbh[31 * (kt >> 1) + 16 * (kt & 1) + rr] : 0.f; v = valid ? v + bias : -1e30f; }
            a[rr] = v; mx = fmaxf(mx, v); }
        S[kt] = a;
    }
    mx = qmax(mx);
    float sum = 0.f; bf16x8 pfr[NT / 2];
#pragma unroll
    for (int kb = 0; kb < NT / 2; ++kb) { f32x4 a0 = S[2 * kb], a1 = S[2 * kb + 1];
#pragma unroll
        for (int rr = 0; rr < 4; ++rr) { a0[rr] = __expf(a0[rr] - mx); a1[rr] = __expf(a1[rr] - mx); sum += a0[rr] + a1[rr]; }
        u32x4 pp; pp.x = pk2(a0[0], a0[1]); pp.y = pk2(a0[2], a0[3]); pp.z = pk2(a1[0], a1[1]); pp.w = pk2(a1[2], a1[3]);
        pfr[kb] = __builtin_bit_cast(bf16x8, pp); }
    sum = qsum(sum);
    __syncthreads();
    if (LOCAL) {
#pragma unroll
        for (int i = 0; i < 8; ++i) { const int idx = tid + 512 * i, row = idx >> 6, ch = idx & 63; *(LAS bf16x8*)(lds + NA_VL + row * 1040 + 16 * ch) = vl[i]; } }
#pragma unroll
    for (int i = 0; i < 4; ++i) { const int idx = tid + 512 * i, row = idx >> 5, ch = idx & 31; *(LAS bf16x8*)(lds + NA_VC + row * 528 + 16 * ch) = vc[i]; }
    asm volatile("s_waitcnt lgkmcnt(0)" ::: "memory"); __syncthreads();
    f32x4 O[4];
#pragma unroll
    for (int dt = 0; dt < 4; ++dt) O[dt] = (f32x4){0.f, 0.f, 0.f, 0.f};
#pragma unroll
    for (int kb = 0; kb < NT / 2; ++kb) {
#pragma unroll
        for (int dt = 0; dt < 4; ++dt) {
            const LAS unsigned char* vp = loc ? lds + NA_VL + (16 * dt + fr) * 1040 + (kb * 64 + kc0 + 4 * fq) * 2
                                              : lds + NA_VC + (16 * dt + fr) * 528 + ((LOCAL ? 0 : 128 * part) + 32 * kb + 4 * fq) * 2;
            O[dt] = mfma16(cat8(*(const LAS bf16x4*)vp, *(const LAS bf16x4*)(vp + 32)), pfr[kb], O[dt]); }
    }
    LAS float* ms = (LAS float*)(lds + NA_MS) + cb * (18 * 64);
    if (part == 1) {
#pragma unroll
        for (int dt = 0; dt < 4; ++dt)
#pragma unroll
            for (int rr = 0; rr < 4; ++rr) ms[(dt * 4 + rr) * 64 + lane] = O[dt][rr];
        ms[16 * 64 + lane] = mx; ms[17 * 64 + lane] = sum;
    }
    asm volatile("s_waitcnt lgkmcnt(0)" ::: "memory"); __syncthreads();
    if (part == 0) {
        const float m2 = ms[16 * 64 + lane], l2 = ms[17 * 64 + lane];
        const float M = fmaxf(mx, m2), e1 = __expf(mx - M), e2 = __expf(m2 - M);
        const float inv = 1.0f / (sum * e1 + l2 * e2);
        bf16* crow = (bf16*)(F.ws + WS_CAT) + (size_t)tokq * D + 1536 + h * 64;
#pragma unroll
        for (int dt = 0; dt < 4; ++dt) { float y[4];
#pragma unroll
            for (int rr = 0; rr < 4; ++rr) y[rr] = (O[dt][rr] * e1 + ms[(dt * 4 + rr) * 64 + lane] * e2) * inv;
            *(bf16x4*)(crow + 16 * dt + 4 * fq) = pk4(y[0], y[1], y[2], y[3]); }
    }
    asm volatile("s_waitcnt lgkmcnt(0)" ::: "memory"); __syncthreads();
}

__global__ void __launch_bounds__(NTHR, 2) mk_fwd(Args args) {
    extern __shared__ __attribute__((aligned(16))) unsigned char lds[];
    Frame F;
    F.lds = (LAS unsigned char*)lds;
    frame_tid(F);
    F.G = gridDim.x; F.in = args.in; F.out = args.out; F.ws = args.ws;
    volatile LAS unsigned* MISC = (volatile LAS unsigned*)(F.lds + LDSCTL_OFF);
    for (int u = F.tid; u < (LDS_BYTES - LDSCTL_OFF) / 4; u += NTHR) MISC[u] = 0u;
    __syncthreads();
#if !MK_SPLIT
    (void)xcd_barrier_post((unsigned*)(args.ws + WS_CTL) + 4096, MISC + 8);
#endif
    const int lo = args.step_lo, hi = args.step_hi;
#define MODL ((const float*)(F.ws + WS_MOD) + (size_t)l * 2 * NMODV)
    int step = 0;
#define IN_STEP() (step >= lo && step < hi && (frame_site(F, args), true))
#if MK_SPLIT
#define END_STEP() do { ++step; } while (0)
#else
#define END_STEP() do { if (step >= lo && step + 1 < hi) { XcdBarrier b_; b_.bar = (unsigned*)(args.ws + WS_CTL) + 4096; b_.x = xb_xcc_id(); b_.st = MISC + 8; for (int rb = 0; rb < REP_BAR; ++rb) xcd_barrier(b_); } ++step; } while (0)
#endif

    if (IN_STEP()) for (int rp = 0; rp < REP_PRO; ++rp) p0_prologue(F);
    END_STEP();

    for (int l = 0; l < DEPTH; ++l) {
        for (int f = 0; f < 2; ++f) {
            if (IN_STEP()) for (int rp = 0; rp < REP_NORM; ++rp) norm_phase(F, F.in[I_NORMG] + (size_t)(l * 3 + 2 * f) * D, MODL, 6 * f, 6 * f + 1, MTOK, f == 0 ? (l == 0 ? 0 : 11) : 4);
            END_STEP();
            if (IN_STEP()) for (int rp = 0; rp < REP_G1; ++rp) {
                pg8::Gemm g{(const bf16*)(F.ws + WS_ABUF), (const bf16*)(F.ws + WS_W13T + (size_t)(l * 2 + f) * SZ_W13T), D, D};
                pg8::StaticOrder S; S.init(MTOK, 2 * DFF, F.G, (int)blockIdx.x);
                pg8::EpiSwiGLU E{(bf16*)(F.ws + WS_HB), DFF};
                pg8::gemm_phase<pg8::EpiSwiGLU, pg8::StaticOrder, true, true>(F.lds, g, S, E);
                if (F.G == 256 && l + 1 < DEPTH && (int)blockIdx.x >= 172) convert_slot(F, l + 1, (f ? 217 : 0) + (int)blockIdx.x - 172);
            }
            END_STEP();
            if (IN_STEP()) {
                {
                const float* gl = MODL + (6 * f + 2) * D; float* H = (float*)(F.ws + WS_H); bf16* HB = (bf16*)(F.ws + WS_HB);
                { pg8::Gemm g{HB, (const bf16*)(F.ws + WS_W2T + (size_t)(l * 2 + f) * SZ_W2T), DFF, DFF};
                  pg8::StaticOrder S; S.init(SEQ, D, F.G, (int)blockIdx.x);
                  pg8::EpiResid E{H, gl};
                  pg8::gemm_phase<pg8::EpiResid, pg8::StaticOrder, true, true>(F.lds, g, S, E); }
                { pg8::Gemm g{HB + (size_t)SEQ * DFF, (const bf16*)(F.ws + WS_W2T + (size_t)(l * 2 + f) * SZ_W2T), DFF, 512};
                  pg8::SplitKOrder S{8, DFF / 512, 512, F.G, (int)blockIdx.x};
                  pg8::EpiSlab E{(float*)(F.ws + WS_SLAB), gl + NMODV, 512};
                  pg8::gemm_phase<pg8::EpiSlab, pg8::SplitKOrder, true, true>(F.lds, g, S, E); }
                }
            }
            END_STEP();
            if (f == 0) {
                if (IN_STEP()) for (int rp = 0; rp < REP_NORM; ++rp) norm_phase(F, F.in[I_NORMG] + (size_t)(l * 3 + 1) * D, MODL, 3, 4, MTOK, 11);
                END_STEP();
                if (IN_STEP()) for (int rp = 0; rp < REP_G3; ++rp) {
                    pg8::Gemm g{(const bf16*)(F.ws + WS_ABUF), (const bf16*)(F.ws + WS_WINT + (size_t)l * SZ_WINT), D, D};
                    pg8::StaticOrder S; S.init(MTOK, DINP, F.G, (int)blockIdx.x);
                    pg8::EpiWin E{(bf16*)(F.ws + WS_P), (float*)(F.ws + WS_GATES), F.in[I_GATEB] + (size_t)l * 32};
                    pg8::gemm_phase<pg8::EpiWin, pg8::StaticOrder, true, true>(F.lds, g, S, E);
                    if (F.G == 256 && l + 1 < DEPTH && (int)blockIdx.x >= 123) convert_slot(F, l + 1, 84 + (int)blockIdx.x - 123);
                }
                END_STEP();
                if (IN_STEP()) for (int rp = 0; rp < REP_PREP; ++rp) prep_phase(F, l);
                END_STEP();
                if (IN_STEP()) for (int rp = 0; rp < REP_LOC; ++rp) {
                    LAS float* wsl = (LAS float*)(F.lds + F.wave * 16384);
                    for (int u = blockIdx.x; u < NCHUNK * 8; u += F.G) mlstm_local_unit(F, u >> 3, u & 7, wsl);
                    for (int v = ((int)blockIdx.x + F.G - (NCHUNK * 8) % F.G) % F.G; v < NCHUNK * 4; v += F.G) sgu_unit(F, l, v >> 2, v & 3);
                }
                END_STEP();
                if (IN_STEP()) for (int rp = 0; rp < REP_SCAN; ++rp) scan_phase(F);
                END_STEP();
                if (IN_STEP()) for (int rp = 0; rp < REP_OUT; ++rp) {
                    const float* rpb = F.in[I_RPB] + (size_t)l * 8 * 15 * 31;
                    LAS float* wsl = (LAS float*)(F.lds + F.wave * 16384);
                    for (int rq = 0; rq < REP_MO; ++rq)
                    for (int u = blockIdx.x; u < NCHUNK * 8; u += F.G) mlstm_out_unit(F, l, u >> 3, u & 7);
                    __syncthreads();
                    for (int rq = 0; rq < REP_NA; ++rq)
                    for (int v = ((int)blockIdx.x + F.G - (NCHUNK * 8) % F.G) % F.G; v < 1024; v += F.G) na_unit<true>(F, rpb, v >> 3, v & 7);
                    for (int v = blockIdx.x; v < 32; v += F.G) na_unit<false>(F, rpb, v >> 3, v & 7);
                }
                END_STEP();
                if (IN_STEP()) {
                    const float* gl = MODL + 5 * D; float* H = (float*)(F.ws + WS_H); bf16* CAT = (bf16*)(F.ws + WS_CAT);
                    { pg8::Gemm g{CAT, (const bf16*)(F.ws + WS_WOUTT + (size_t)l * SZ_WOUTT), D, D};
                      pg8::StaticOrder S; S.init(SEQ, D, F.G, (int)blockIdx.x);
                      pg8::EpiResid E{H, gl};
                      pg8::gemm_phase<pg8::EpiResid, pg8::StaticOrder, true, true>(F.lds, g, S, E); }
                    { pg8::Gemm g{CAT + (size_t)SEQ * D, (const bf16*)(F.ws + WS_WOUTT + (size_t)l * SZ_WOUTT), D, 512};
                      pg8::SplitKOrder S{8, D / 512, 512, F.G, (int)blockIdx.x};
                      pg8::EpiSlab E{(float*)(F.ws + WS_SLAB), gl + NMODV, 512};
                      pg8::gemm_phase<pg8::EpiSlab, pg8::SplitKOrder, true, true>(F.lds, g, S, E); }
                }
                END_STEP();
            }
        }
    }
    if (IN_STEP()) final_norm_phase(F);
#undef MODL
#undef IN_STEP
#undef END_STEP
}
constexpr int N_STEPS = 1 + DEPTH * 13 + 1;

extern "C" void kernel_launch(void* const* d_in, const int* in_sizes, int n_in, void* d_out, int out_size, void* d_ws, size_t ws_size, hipStream_t stream) {
    static int grid = 0;
    if (grid == 0) {
        if (n_in != 22 || out_size != SEQ * D || ws_size < WS_END) { fprintf(stderr, "kernel_launch: unexpected shapes (n_in %d, out %d, ws %zu < %zu)\n", n_in, out_size, ws_size, (size_t)WS_END); grid = -1; return; }
        int dev = 0, cus = 0, per_cu = 0;
        if (hipGetDevice(&dev) != hipSuccess || hipDeviceGetAttribute(&cus, hipDeviceAttributeMultiprocessorCount, dev) != hipSuccess) { grid = -1; return; }
        if (hipFuncSetAttribute((const void*)mk_fwd, hipFuncAttributeMaxDynamicSharedMemorySize, LDS_BYTES) != hipSuccess) { fprintf(stderr, "kernel_launch: hipFuncSetAttribute failed\n"); grid = -1; return; }
        if (hipOccupancyMaxActiveBlocksPerMultiprocessor(&per_cu, (const void*)mk_fwd, NTHR, LDS_BYTES) != hipSuccess || per_cu < 1) fprintf(stderr, "kernel_launch: occupancy query says %d\n", per_cu);
        (void)hipGetLastError();
        grid = cus;
    }
    if (grid < 0) return;
    (void)hipMemsetAsync((char*)d_ws + WS_CTL, 0, CTL_ZERO_BYTES, stream);
    Args a{};
    for (int i = 0; i < 22; ++i) a.in[i] = (const float*)d_in[i];
    a.out = (float*)d_out; a.ws = (unsigned char*)d_ws;
#if MK_SPLIT
    for (int s = 0; s < N_STEPS; ++s) { a.step_lo = s; a.step_hi = s + 1; hipLaunchKernelGGL(mk_fwd, dim3(grid), dim3(NTHR), LDS_BYTES, stream, a); }
#else
    a.step_lo = 0; a.step_hi = N_STEPS;
    hipLaunchKernelGGL(mk_fwd, dim3(grid), dim3(NTHR), LDS_BYTES, stream, a);
#endif
    const hipError_t le = hipPeekAtLastError();
    if (le != hipSuccess) fprintf(stderr, "kernel_launch: launch failed: %s\n", hipGetErrorName(le));
}
```
